# Optimizing an MI355X kernel written in HIP

```python
import jax, jax.numpy as jnp
from jax import lax
import numpy as np

D_MODEL = 1024
BATCH = 4
SEQ = 4096
DEPTH = 2
DEC_BATCH = 32
DEC_SEQ = 1
PAST_LEN = 8192
PAGE_SIZE = 128

HEAD_DIM = 64
N_FOX_HEADS = 8
N_RET_HEADS = 8
FOX_WIDTH = N_FOX_HEADS * HEAD_DIM
RET_WIDTH = N_RET_HEADS * HEAD_DIM
EVEN_IN = 3 * FOX_WIDTH + N_FOX_HEADS + 4 * RET_WIDTH
CONV_WIDTH = 3
D_FF = 2816
Q_BLOCK = 128
RET_CHUNK = 128
RET_ANGLE_BASE = 10000.0
N_EVEN = (DEPTH + 1) // 2
N_ODD = DEPTH // 2
N_MOD = 9
DEEPNORM_ALPHA = (2.0 * DEPTH) ** 0.25
DEEPNORM_BETA = (8.0 * DEPTH) ** -0.25
LN_EPS = 1e-5
GN_EPS = 1e-6

kernel_name = "fox_retnet_shortconv_macaron_deepnorm_adaln_step"


def _layernorm(x, g, b):
    xf = x.astype(jnp.float32)
    mu = jnp.mean(xf, axis=-1, keepdims=True)
    var = jnp.mean(jnp.square(xf - mu), axis=-1, keepdims=True)
    return ((xf - mu) * lax.rsqrt(var + LN_EPS) * g + b).astype(x.dtype)


def _head_norm(o):
    of = o.astype(jnp.float32)
    mu = jnp.mean(of, axis=-1, keepdims=True)
    var = jnp.mean(jnp.square(of - mu), axis=-1, keepdims=True)
    return (of - mu) * lax.rsqrt(var + GN_EPS)


def _swiglu(h, w_in, w_out):
    a, b = jnp.split(h @ w_in, 2, axis=-1)
    return (jax.nn.silu(a) * b) @ w_out


def _rotary(x, pos):
    half = x.shape[-1] // 2
    inv = 1.0 / (RET_ANGLE_BASE ** jnp.linspace(0.0, 1.0, half, dtype=jnp.float32))
    ang = pos.astype(jnp.float32)[:, None] * inv[None, :]
    cos = jnp.cos(ang)[None, :, None, :]
    sin = jnp.sin(ang)[None, :, None, :]
    x1 = x[..., :half].astype(jnp.float32)
    x2 = x[..., half:].astype(jnp.float32)
    return jnp.concatenate([x1 * cos - x2 * sin, x1 * sin + x2 * cos], axis=-1).astype(x.dtype)


def _fox_attend(q, cq, qpos, k, ck, kpos, v):
    s = jnp.einsum('bqhd,bkhd->bhqk', q, k).astype(jnp.float32) * (HEAD_DIM ** -0.5)
    s = s + (jnp.transpose(cq, (0, 2, 1))[:, :, :, None] - jnp.transpose(ck, (0, 2, 1))[:, :, None, :])
    mask = kpos[None, :] <= qpos[:, None]
    s = jnp.where(mask[None, None], s, -jnp.inf)
    p = jax.nn.softmax(s, axis=-1)
    return jnp.einsum('bhqk,bkhd->bqhd', p.astype(v.dtype), v)


def _fox_prompt(q, k, v, logf):
    B, T, H, d = q.shape
    c = jnp.cumsum(logf.astype(jnp.float32), axis=1)
    nb = T // Q_BLOCK
    qb = q.reshape(B, nb, Q_BLOCK, H, d).transpose(1, 0, 2, 3, 4)
    cb = c.reshape(B, nb, Q_BLOCK, H).transpose(1, 0, 2, 3)
    pb = jnp.arange(T, dtype=jnp.int32).reshape(nb, Q_BLOCK)
    kpos = jnp.arange(T, dtype=jnp.int32)
    out = lax.map(lambda a: _fox_attend(a[0], a[1], a[2], k, c, kpos, v), (qb, cb, pb))
    return out.transpose(1, 0, 2, 3, 4).reshape(B, T, H, d)


def _fox_sample(q, k, v, logf, k_past, v_past, logf_past):
    P = k_past.shape[1]
    L = q.shape[1]
    k_all = jnp.concatenate([k_past.astype(k.dtype), k], axis=1)
    v_all = jnp.concatenate([v_past.astype(v.dtype), v], axis=1)
    c_all = jnp.cumsum(jnp.concatenate([logf_past.astype(jnp.float32), logf.astype(jnp.float32)], axis=1), axis=1)
    qpos = P + jnp.arange(L, dtype=jnp.int32)
    kpos = jnp.arange(P + L, dtype=jnp.int32)
    return _fox_attend(q, c_all[:, P:], qpos, k_all, c_all, kpos, v_all)


def _ret_log_decay():
    return jnp.log(1.0 - 2.0 ** (-5.0 - jnp.arange(N_RET_HEADS, dtype=jnp.float32)))


def _ret_chunk(S, q, k, v, lg):
    L = q.shape[1]
    i = jnp.arange(L, dtype=jnp.float32)
    diff = i[:, None] - i[None, :]
    dmask = jnp.where(diff[None] >= 0, jnp.exp(jnp.maximum(diff, 0.0)[None] * lg[:, None, None]), 0.0)
    qf = q.astype(jnp.float32)
    kf = k.astype(jnp.float32)
    vf = v.astype(jnp.float32)
    qk = jnp.einsum('bihd,bjhd->bhij', qf, kf) * dmask[None]
    inner = jnp.einsum('bhij,bjhe->bihe', qk, vf)
    cross = jnp.einsum('bihd,bhde->bihe', qf, S) * jnp.exp((i + 1.0)[:, None] * lg[None, :])[None, :, :, None]
    kd = kf * jnp.exp((L - 1.0 - i)[:, None] * lg[None, :])[None, :, :, None]
    S_new = jnp.exp(L * lg)[None, :, None, None] * S + jnp.einsum('bjhd,bjhe->bhde', kd, vf)
    return S_new, inner + cross


def _ret_scan(q, k, v, S0):
    B, T, H, _ = q.shape
    lg = _ret_log_decay()
    S0 = S0.astype(jnp.float32)
    if T % RET_CHUNK != 0:
        return _ret_chunk(S0, q, k, v, lg)
    n = T // RET_CHUNK

    def to_chunks(a):
        return a.reshape(B, n, RET_CHUNK, H, a.shape[-1]).swapaxes(0, 1)

    S, o = lax.scan(lambda s, a: _ret_chunk(s, a[0], a[1], a[2], lg), S0, (to_chunks(q), to_chunks(k), to_chunks(v)))
    return S, o.swapaxes(0, 1).reshape(B, T, H, -1)


def _even_mixer(h, pos, w_in, b_f, w_out, fox_past, S0):
    B, T, _ = h.shape
    F, R, Hf = FOX_WIDTH, RET_WIDTH, N_FOX_HEADS
    split_at = [F, 2 * F, 3 * F, 3 * F + Hf, 3 * F + Hf + R, 3 * F + Hf + 2 * R, 3 * F + Hf + 3 * R]
    qf, kf, vf, fg, qr, kr, vr, gr = jnp.split(h @ w_in, split_at, axis=-1)

    def heads(a):
        return a.reshape(B, T, -1, HEAD_DIM)

    qf, kf, vf = heads(qf), heads(kf), heads(vf)
    logf = jax.nn.log_sigmoid((fg + b_f).astype(jnp.float32))
    if fox_past is None:
        of = _fox_prompt(qf, kf, vf, logf)
    else:
        of = _fox_sample(qf, kf, vf, logf, fox_past[0], fox_past[1], fox_past[2])
    qr = _rotary(heads(qr), pos)
    kr = _rotary(heads(kr), pos) * (HEAD_DIM ** -0.5)
    S, orr = _ret_scan(qr, kr, heads(vr), S0)
    yr = jax.nn.silu(gr) * _head_norm(orr).reshape(B, T, R).astype(h.dtype)
    y = jnp.concatenate([of.reshape(B, T, F).astype(h.dtype), yr], axis=-1) @ w_out
    return y, kf, vf, logf, S


def _odd_mixer(h, w_in, conv_w, w_out, buf):
    T = h.shape[1]
    b_gate, c_gate, u = jnp.split(h @ w_in, 3, axis=-1)
    u = c_gate * u
    up = jnp.concatenate([buf.astype(u.dtype), u], axis=1)
    z = conv_w[0] * up[:, 0:T]
    for j in range(1, CONV_WIDTH):
        z = z + conv_w[j] * up[:, j:j + T]
    y = (b_gate * z) @ w_out
    return y, up[:, -(CONV_WIDTH - 1):]


def _trunk(x, c, pos, fox_cache, ret_state, conv_state, page_table, w_ada, b_ada, w_ffn_in, w_ffn_out,
           ln_g, ln_b, w_in_even, b_forget, w_out_even, w_in_odd, conv_w, w_out_odd):
    B = x.shape[0]
    ks, vs, lfs, Ss, convs = [], [], [], [], []
    for l in range(DEPTH):
        mods = (jax.nn.silu(c) @ w_ada[l] + b_ada[l]).reshape(B, 1, N_MOD, D_MODEL)
        sh, sc, g = mods[:, :, 0], mods[:, :, 1], mods[:, :, 2]
        f = _swiglu(x * (1.0 + sc) + sh, w_ffn_in[l, 0], w_ffn_out[l, 0])
        x = _layernorm(DEEPNORM_ALPHA * x + 0.5 * g * f, ln_g[l, 0], ln_b[l, 0])
        sh, sc, g = mods[:, :, 3], mods[:, :, 4], mods[:, :, 5]
        h = x * (1.0 + sc) + sh
        if l % 2 == 0:
            e = l // 2
            if fox_cache is None:
                fox_past = None
                s0 = jnp.zeros((B, N_RET_HEADS, HEAD_DIM, HEAD_DIM), jnp.float32)
            else:
                k_pool, v_pool, lf_pool = fox_cache
                fox_past = (k_pool[e][page_table].reshape(B, -1, N_FOX_HEADS, HEAD_DIM),
                            v_pool[e][page_table].reshape(B, -1, N_FOX_HEADS, HEAD_DIM),
                            lf_pool[e][page_table].reshape(B, -1, N_FOX_HEADS))
                s0 = ret_state[e]
            y, kn, vn, lfn, Sn = _even_mixer(h, pos, w_in_even[e], b_forget[e], w_out_even[e], fox_past, s0)
            ks.append(kn)
            vs.append(vn)
            lfs.append(lfn)
            Ss.append(Sn)
        else:
            o = l // 2
            buf = jnp.zeros((B, CONV_WIDTH - 1, D_MODEL), x.dtype) if conv_state is None else conv_state[o]
            y, nbuf = _odd_mixer(h, w_in_odd[o], conv_w[o], w_out_odd[o], buf)
            convs.append(nbuf)
        x = _layernorm(DEEPNORM_ALPHA * x + g * y, ln_g[l, 1], ln_b[l, 1])
        sh, sc, g = mods[:, :, 6], mods[:, :, 7], mods[:, :, 8]
        f = _swiglu(x * (1.0 + sc) + sh, w_ffn_in[l, 1], w_ffn_out[l, 1])
        x = _layernorm(DEEPNORM_ALPHA * x + 0.5 * g * f, ln_g[l, 2], ln_b[l, 2])
    return x, jnp.stack(ks), jnp.stack(vs), jnp.stack(lfs), jnp.stack(Ss), jnp.stack(convs)


def setup_inputs(seed: int = 0) -> dict:
    key = jax.random.key(seed)
    k = jax.random.split(key, 24)

    def nrm(kk, shape, scale):
        return jax.random.normal(kk, shape, jnp.float32) * scale

    n_pages = PAST_LEN // PAGE_SIZE
    used = DEC_BATCH * n_pages
    n_phys = used + max(1, used // 4)
    page_table = jax.random.permutation(k[0], n_phys)[:used].reshape(DEC_BATCH, n_pages).astype(jnp.int32)
    d = D_MODEL
    return {
        "x_prompt": nrm(k[1], (BATCH, SEQ, d), 1.0),
        "x_sample": nrm(k[2], (DEC_BATCH, DEC_SEQ, d), 1.0),
        "cache_k": nrm(k[3], (N_EVEN, n_phys, PAGE_SIZE, N_FOX_HEADS, HEAD_DIM), 1.0),
        "cache_v": nrm(k[4], (N_EVEN, n_phys, PAGE_SIZE, N_FOX_HEADS, HEAD_DIM), 1.0),
        "cache_logf": jax.nn.log_sigmoid(3.0 + nrm(k[5], (N_EVEN, n_phys, PAGE_SIZE, N_FOX_HEADS), 1.0)),
        "state_ret": nrm(k[6], (N_EVEN, DEC_BATCH, N_RET_HEADS, HEAD_DIM, HEAD_DIM), 0.5),
        "state_conv": nrm(k[7], (N_ODD, DEC_BATCH, CONV_WIDTH - 1, d), 1.0),
        "page_table": page_table,
        "c_prompt": nrm(k[8], (BATCH, d), 1.0),
        "c_sample": nrm(k[9], (DEC_BATCH, d), 1.0),
        "w_ada": nrm(k[10], (DEPTH, d, N_MOD * d), 0.5 * d ** -0.5),
        "b_ada": nrm(k[11], (DEPTH, N_MOD * d), 0.01),
        "w_ffn_in": nrm(k[12], (DEPTH, 2, d, 2 * D_FF), d ** -0.5),
        "w_ffn_out": nrm(k[13], (DEPTH, 2, D_FF, d), DEEPNORM_BETA * D_FF ** -0.5),
        "ln_g": 1.0 + nrm(k[14], (DEPTH, 3, d), 0.01),
        "ln_b": nrm(k[15], (DEPTH, 3, d), 0.01),
        "w_in_even": nrm(k[16], (N_EVEN, d, EVEN_IN), d ** -0.5),
        "b_forget": 3.0 + nrm(k[17], (N_EVEN, N_FOX_HEADS), 0.5),
        "w_out_even": nrm(k[18], (N_EVEN, d, d), DEEPNORM_BETA * d ** -0.5),
        "w_in_odd": nrm(k[19], (N_ODD, d, 3 * d), d ** -0.5),
        "conv_w": nrm(k[20], (N_ODD, CONV_WIDTH, d), CONV_WIDTH ** -0.5),
        "w_out_odd": nrm(k[21], (N_ODD, d, d), DEEPNORM_BETA * d ** -0.5),
    }


def reference(x_prompt, x_sample, cache_k, cache_v, cache_logf, state_ret, state_conv, page_table,
              c_prompt, c_sample, w_ada, b_ada, w_ffn_in, w_ffn_out, ln_g, ln_b,
              w_in_even, b_forget, w_out_even, w_in_odd, conv_w, w_out_odd):
    pos_prompt = jnp.arange(x_prompt.shape[1], dtype=jnp.int32)
    pos_sample = PAST_LEN + jnp.arange(x_sample.shape[1], dtype=jnp.int32)
    y_prompt, k_p, v_p, lf_p, ret_p, conv_p = _trunk(
        x_prompt, c_prompt, pos_prompt, None, None, None, None,
        w_ada, b_ada, w_ffn_in, w_ffn_out, ln_g, ln_b,
        w_in_even, b_forget, w_out_even, w_in_odd, conv_w, w_out_odd)
    y_sample, k_s, v_s, lf_s, ret_s, conv_s = _trunk(
        x_sample, c_sample, pos_sample, (cache_k, cache_v, cache_logf), state_ret, state_conv, page_table,
        w_ada, b_ada, w_ffn_in, w_ffn_out, ln_g, ln_b,
        w_in_even, b_forget, w_out_even, w_in_odd, conv_w, w_out_odd)
    return (y_prompt, y_sample, k_p, v_p, lf_p, ret_p, conv_p, k_s, v_s, lf_s, ret_s, conv_s)
```

```cpp
#define MK_PER_PHASE 1
#include <hip/hip_runtime.h>
#include <cstdio>
#include <cstdint>
namespace pg8 {
#define PG8_LAS __attribute__((address_space(3)))
typedef unsigned short bf16_t;
typedef short bf16x8 __attribute__((ext_vector_type(8)));
typedef float f32x4 __attribute__((ext_vector_type(4)));
typedef unsigned u32x4 __attribute__((ext_vector_type(4)));
constexpr int BM = 256, BK = 64, HALF = 128, HTB = HALF * BK * 2  , STAGE_BYTES = 8 * HTB, NXCD = 8, WGM = 8;

__host__ __device__ __forceinline__ int lds_byte(int r, int c) { const int st = (r >> 4) * 2 + (c >> 5), rr = r & 15, cc = c & 31, ob = rr * 64 + cc * 2; return st * 1024 + (ob ^ (((ob >> 9) & 1) << 5)); }
__host__ __device__ __forceinline__ void stage_rc(int b, int& R, int& C) { const int st = b / 1024, sb = b % 1024, swz = sb ^ (((sb >> 9) & 1) << 5); R = (st >> 1) * 16 + swz / 64; C = (st & 1) * 32 + (swz % 64) / 2; }
__host__ __device__ __forceinline__ int perm32(int rho) { const int n = rho >> 4, i = rho & 15; return 8 * (i >> 2) + 4 * n + (i & 3); }

struct Unit { int pm, pn; };
struct Gemm { const bf16_t* A; const bf16_t* Bt; int M, N, K; };

struct StaticOrder {
    int nM, nN, nwg, G, c;
    __host__ __device__ void init(int M, int N, int G_, int c_) { nM = M / BM; nN = N / BM; nwg = nM * nN; G = G_; c = c_; }
    __host__ __device__ bool next(int i, Unit& u) const {
        const long L = (long)i * G + c; if (L >= nwg) return false;
        int wgid = (int)L; { const int q = nwg / NXCD, r = nwg % NXCD, xcd = wgid % NXCD, off = wgid / NXCD; wgid = (xcd < r ? xcd * (q + 1) : r * (q + 1) + (xcd - r) * q) + off; }
        const int nig = WGM * nN, gid = wgid / nig, fm = gid * WGM, gsz = (nM - fm) < WGM ? (nM - fm) : WGM;
        u.pm = fm + ((wgid % nig) % gsz); u.pn = (wgid % nig) / gsz; return true;
    }
    __device__ __forceinline__ void a_ready(const Unit&) const {}
    __device__ __forceinline__ void done(const Unit&) const {}
};

__device__ __forceinline__ unsigned cvt_pk_bf16(float lo, float hi) { unsigned r; asm volatile("v_cvt_pk_bf16_f32 %0, %1, %2" : "=v"(r) : "v"(lo), "v"(hi)); return r; }
typedef float f32x2 __attribute__((ext_vector_type(2)));

constexpr int EP_M = 16384;
constexpr int EP_MS = EP_M + 32;
__device__ __forceinline__ u32x4 pack8(const f32x4& v0, const f32x4& v1) { u32x4 w; w.x = cvt_pk_bf16(v0[0], v0[1]); w.y = cvt_pk_bf16(v0[2], v0[3]); w.z = cvt_pk_bf16(v1[0], v1[1]); w.w = cvt_pk_bf16(v1[2], v1[3]); return w; }
__device__ __forceinline__ float silu_f(float a) { return a * __builtin_amdgcn_rcpf(1.0f + __builtin_amdgcn_exp2f(-1.4426950408889634f * a)); }
__device__ __forceinline__ float log_sigmoid_f(float x) { return fminf(x, 0.f) - log1pf(__expf(-fabsf(x))); }

struct EpiPlain {
    static constexpr bool PERM = true, AFTER_DRAIN = false;
    bf16_t* O; int ldc;
    __device__ __forceinline__ void operator()(const f32x4 (&acc)[2][2][4][2], const Unit& u, int wr, int wc, int fr, int fq) const {
        const int row0 = u.pm * BM + wr * 64 + fr, col0 = u.pn * BM + wc * 32 + 8 * fq;
#pragma unroll
        for (int ai = 0; ai < 2; ++ai)
#pragma unroll
            for (int m = 0; m < 4; ++m) { bf16_t* rowp = O + (size_t)(row0 + ai * HALF + m * 16) * ldc + col0;
#pragma unroll
                for (int bj = 0; bj < 2; ++bj) *(u32x4*)(rowp + bj * HALF) = pack8(acc[ai][bj][m][0], acc[ai][bj][m][1]); }
    }
};
struct EpiSwiGLU {
    static constexpr bool PERM = true, AFTER_DRAIN = false;
    bf16_t* O; int ldc;
    __device__ __forceinline__ void operator()(const f32x4 (&acc)[2][2][4][2], const Unit& u, int wr, int wc, int fr, int fq) const {
        const int row0 = u.pm * BM + wr * 64 + fr, col0 = u.pn * HALF + wc * 32 + 8 * fq;
#pragma unroll
        for (int ai = 0; ai < 2; ++ai)
#pragma unroll
            for (int m = 0; m < 4; ++m) { bf16_t* rowp = O + (size_t)(row0 + ai * HALF + m * 16) * ldc + col0;
                f32x4 h0, h1;
#pragma unroll
                for (int e = 0; e < 4; ++e) { h0[e] = silu_f(acc[ai][0][m][0][e]) * acc[ai][1][m][0][e]; h1[e] = silu_f(acc[ai][0][m][1][e]) * acc[ai][1][m][1][e]; }
                *(u32x4*)rowp = pack8(h0, h1); }
    }
};
struct EpiEvenProj {
    static constexpr bool PERM = true, AFTER_DRAIN = false;
    bf16_t* P; float* outK; float* outV; float* outLf; float* outKs; float* outVs; float* outLfs; float* logf_ws; const float* bfor; float qscale;
    __device__ __forceinline__ void operator()(const f32x4 (&acc)[2][2][4][2], const Unit& u, int wr, int wc, int fr, int fq) const {
        const int row0 = u.pm * BM + wr * 64 + fr; const int pn = u.pn;
        if (pn < 14) {
            const float sc = pn < 2 ? qscale : 1.0f; const int col0 = pn * BM + wc * 32 + 8 * fq;
            const bool kv = (pn >= 2 && pn < 6);
#pragma unroll
            for (int ai = 0; ai < 2; ++ai)
#pragma unroll
                for (int m = 0; m < 4; ++m) { const int row = row0 + ai * HALF + m * 16; bf16_t* rowp = P + (size_t)row * 3584 + col0;
#pragma unroll
                    for (int bj = 0; bj < 2; ++bj) { const f32x4 v0 = acc[ai][bj][m][0] * sc, v1 = acc[ai][bj][m][1] * sc; *(u32x4*)(rowp + bj * HALF) = pack8(v0, v1);
                        if (kv && row < EP_MS) { const int c = col0 + bj * HALF - (pn < 4 ? 512 : 1024);
                            float* dst = row < EP_M ? ((pn < 4 ? outK : outV) + (size_t)row * 512 + c) : ((pn < 4 ? outKs : outVs) + (size_t)(row - EP_M) * 512 + c);
                            *(f32x4*)dst = v0; *(f32x4*)(dst + 4) = v1; } } }
        } else if (wc == 0 && fq == 0) {
            const f32x4 b0 = *(const f32x4*)bfor, b1 = *(const f32x4*)(bfor + 4);
#pragma unroll
            for (int ai = 0; ai < 2; ++ai)
#pragma unroll
                for (int m = 0; m < 4; ++m) { const int row = row0 + ai * HALF + m * 16; f32x4 l0, l1;
#pragma unroll
                    for (int e = 0; e < 4; ++e) { l0[e] = log_sigmoid_f(acc[ai][0][m][0][e] + b0[e]); l1[e] = log_sigmoid_f(acc[ai][0][m][1][e] + b1[e]); }
                    *(f32x4*)(logf_ws + (size_t)row * 8) = l0; *(f32x4*)(logf_ws + (size_t)row * 8 + 4) = l1;
                    if (row < EP_MS) { float* dst = row < EP_M ? outLf + (size_t)row * 8 : outLfs + (size_t)(row - EP_M) * 8; *(f32x4*)dst = l0; *(f32x4*)(dst + 4) = l1; } }
        }
    }
};
struct EpiOddProj {
    static constexpr bool PERM = true, AFTER_DRAIN = false;
    bf16_t* UP; bf16_t* BG; float* outConv; float* outConvS;
    __device__ __forceinline__ void operator()(const f32x4 (&acc)[2][2][4][2], const Unit& u, int wr, int wc, int fr, int fq) const {
        const int row0 = u.pm * BM + wr * 64 + fr; const int pn = u.pn;
        if (pn < 8) {
            const int col0 = pn * HALF + wc * 32 + 8 * fq;
#pragma unroll
            for (int ai = 0; ai < 2; ++ai)
#pragma unroll
                for (int m = 0; m < 4; ++m) { const int row = row0 + ai * HALF + m * 16;
                    const f32x4 h0 = acc[ai][0][m][0] * acc[ai][1][m][0], h1 = acc[ai][0][m][1] * acc[ai][1][m][1];
                    *(u32x4*)(UP + (size_t)row * 1024 + col0) = pack8(h0, h1);
                    if (row < EP_M) { const int t = row & 4095; if (t >= 4094) { float* dst = outConv + ((size_t)(row >> 12) * 2 + (t - 4094)) * 1024 + col0; *(f32x4*)dst = h0; *(f32x4*)(dst + 4) = h1; } }
                    else if (row < EP_MS) { float* dst = outConvS + ((size_t)(row - EP_M) * 2 + 1) * 1024 + col0; *(f32x4*)dst = h0; *(f32x4*)(dst + 4) = h1; } }
        } else {
            const int col0 = (pn - 8) * BM + wc * 32 + 8 * fq;
#pragma unroll
            for (int ai = 0; ai < 2; ++ai)
#pragma unroll
                for (int m = 0; m < 4; ++m) { bf16_t* rowp = BG + (size_t)(row0 + ai * HALF + m * 16) * 1024 + col0;
#pragma unroll
                    for (int bj = 0; bj < 2; ++bj) *(u32x4*)(rowp + bj * HALF) = pack8(acc[ai][bj][m][0], acc[ai][bj][m][1]); }
        }
    }
};
template <class Epi, class Sched, bool ALIGN_EPI = false, bool SP2 = false>
__device__ __forceinline__ void gemm_phase(PG8_LAS unsigned char* lds, const Gemm g, const Sched& S, const Epi& E) {
    int tid_l = threadIdx.x; asm volatile("" : "+v"(tid_l)); const int tid = tid_l, wid = __builtin_amdgcn_readfirstlane(tid >> 6), lane = tid & 63, wr = wid >> 2, wc = wid & 3, fr = lane & 15, fq = lane >> 4;
    const int K = g.K, nt = K / BK;
    unsigned voffA[2], voffB[2];
#pragma unroll
    for (int i = 0; i < 2; ++i) { int R, C; stage_rc(tid * 16 + i * 8192, R, C); const int Rb = Epi::PERM ? ((R & ~31) + perm32(R & 31)) : R;
        voffA[i] = (unsigned)(R * K + C) * 2u; voffB[i] = (unsigned)(Rb * K + C) * 2u; }
    const size_t kstep = (size_t)(BK * 2);
    const size_t hstep = (size_t)HALF * K * 2;
    const size_t tstep = 2 * hstep;
    const unsigned ldsw = (unsigned)wid * 1024u;
    const int aoff = lds_byte(wr * 64 + fr, fq * 8), boff = lds_byte(wc * 32 + fr, fq * 8);
#define PG8_SA(b, h) (((b) * 2 + (h)) * HTB)
#define PG8_SB(b, h) ((4 + (b) * 2 + (h)) * HTB)
#define PG8_STAGE(bufoff, gbase, voff) do { _Pragma("unroll") for (int _i = 0; _i < 2; ++_i) \
        __builtin_amdgcn_global_load_lds((const unsigned*)((const char*)(gbase) + (voff)[_i]), (PG8_LAS unsigned*)(lds + (bufoff) + ldsw + _i * 8192), 16, 0, 0); } while (0)
#define PG8_LDA(dst, b, h) do { _Pragma("unroll") for (int m = 0; m < 4; ++m) _Pragma("unroll") for (int k = 0; k < 2; ++k) dst[m][k] = *(const PG8_LAS bf16x8*)(lds + PG8_SA(b, h) + aoff + m * 2048 + k * 1024); } while (0)
#define PG8_LDB(dst, b, h) do { _Pragma("unroll") for (int n = 0; n < 2; ++n) _Pragma("unroll") for (int k = 0; k < 2; ++k) dst[n][k] = *(const PG8_LAS bf16x8*)(lds + PG8_SB(b, h) + boff + n * 2048 + k * 1024); } while (0)
#define PG8_MMA(ai, bj, At, Bt) do { __builtin_amdgcn_s_setprio(1); _Pragma("unroll") for (int m = 0; m < 4; ++m) _Pragma("unroll") for (int n = 0; n < 2; ++n) _Pragma("unroll") for (int k = 0; k < 2; ++k) \
        acc[ai][bj][m][n] = __builtin_amdgcn_mfma_f32_16x16x32_bf16(Bt[n][k], At[m][k], acc[ai][bj][m][n], 0, 0, 0); __builtin_amdgcn_s_setprio(0); } while (0)
#define PG8_WAIT_V(n) asm volatile("s_waitcnt vmcnt(" #n ")" ::: "memory")
#define PG8_WAIT_L(n) asm volatile("s_waitcnt lgkmcnt(" #n ")" ::: "memory")
#define PG8_BAR __builtin_amdgcn_s_barrier()
#define PG8_SCHED __builtin_amdgcn_sched_barrier(0)
    Unit cur, nxt; int ui = 0;
    if (!S.next(0, cur)) return;
    f32x4 acc[2][2][4][2];
#pragma unroll
    for (int a = 0; a < 2; ++a)
#pragma unroll
        for (int b = 0; b < 2; ++b)
#pragma unroll
            for (int m = 0; m < 4; ++m)
#pragma unroll
                for (int n = 0; n < 2; ++n) acc[a][b][m][n] = (f32x4){0.f, 0.f, 0.f, 0.f};
    bf16x8 At[4][2], B0[2][2], B1[2][2];
    const char* cA = (const char*)g.A + (size_t)cur.pm * tstep; const char* cB = (const char*)g.Bt + (size_t)cur.pn * tstep;
    S.a_ready(cur);
    if constexpr (SP2) {
        PG8_STAGE(PG8_SB(0, 0), cB, voffB); PG8_STAGE(PG8_SB(0, 1), cB + hstep, voffB); PG8_STAGE(PG8_SA(0, 0), cA, voffA); PG8_STAGE(PG8_SA(0, 1), cA + hstep, voffA);
        if (wr == 1) PG8_BAR;
        PG8_WAIT_V(2); PG8_BAR;
        PG8_STAGE(PG8_SB(1, 0), cB + kstep, voffB); PG8_STAGE(PG8_SA(1, 0), cA + kstep, voffA); PG8_STAGE(PG8_SB(1, 1), cB + hstep + kstep, voffB);
        PG8_WAIT_V(6); PG8_BAR;
    } else {
        PG8_STAGE(PG8_SB(0, 0), cB, voffB); PG8_STAGE(PG8_SA(0, 0), cA, voffA); PG8_STAGE(PG8_SB(0, 1), cB + hstep, voffB); PG8_STAGE(PG8_SA(0, 1), cA + hstep, voffA);
        if (wr == 1) PG8_BAR;
        PG8_WAIT_V(4); PG8_BAR;
        PG8_STAGE(PG8_SB(1, 0), cB + kstep, voffB); PG8_STAGE(PG8_SA(1, 0), cA + kstep, voffA); PG8_STAGE(PG8_SB(1, 1), cB + hstep + kstep, voffB);
        PG8_WAIT_V(6); PG8_BAR;
    }
    for (;;) {
        const bool has_next = S.next(ui + 1, nxt);
        const char* nA = has_next ? (const char*)g.A + (size_t)nxt.pm * tstep : cA; const char* nB = has_next ? (const char*)g.Bt + (size_t)nxt.pn * tstep : cB;
        for (int t = 0; t < nt; t += 2) {
            const bool last = (t == nt - 2);
            const char* a1 = cA + (size_t)(t + 1) * kstep;
            const char* a2 = last ? nA : cA + (size_t)(t + 2) * kstep; const char* b2 = last ? nB : cB + (size_t)(t + 2) * kstep;
            const char* a3 = a2 + kstep; const char* b3 = b2 + kstep;
            if (last && has_next) S.a_ready(nxt);
            if constexpr (SP2) {
            PG8_LDB(B0, 0, 0); PG8_LDB(B1, 0, 1); PG8_SCHED; PG8_LDA(At, 0, 0); PG8_STAGE(PG8_SA(1, 1), a1 + hstep, voffA);
            PG8_WAIT_V(8); PG8_WAIT_L(0); PG8_BAR; PG8_MMA(0, 0, At, B0); PG8_MMA(0, 1, At, B1); PG8_BAR; PG8_SCHED;
            PG8_LDA(At, 0, 1); PG8_STAGE(PG8_SB(0, 0), b2, voffB); PG8_STAGE(PG8_SB(0, 1), b2 + hstep, voffB); PG8_STAGE(PG8_SA(0, 0), a2, voffA);
            PG8_WAIT_V(8); PG8_WAIT_L(0); PG8_BAR; PG8_MMA(1, 0, At, B0); PG8_MMA(1, 1, At, B1); PG8_BAR; PG8_SCHED;
            PG8_LDB(B0, 1, 0); PG8_LDB(B1, 1, 1); PG8_SCHED; PG8_LDA(At, 1, 0); PG8_STAGE(PG8_SA(0, 1), a2 + hstep, voffA);
            PG8_WAIT_V(8); PG8_WAIT_L(0); PG8_BAR; PG8_MMA(0, 0, At, B0); PG8_MMA(0, 1, At, B1); PG8_BAR; PG8_SCHED;
            PG8_LDA(At, 1, 1); PG8_STAGE(PG8_SB(1, 0), b3, voffB); PG8_STAGE(PG8_SB(1, 1), b3 + hstep, voffB); PG8_STAGE(PG8_SA(1, 0), a3, voffA);
            PG8_WAIT_V(8); PG8_WAIT_L(0); PG8_BAR; PG8_MMA(1, 0, At, B0); PG8_MMA(1, 1, At, B1); PG8_BAR; PG8_SCHED;
            } else {
            PG8_LDB(B0, 0, 0); PG8_SCHED; PG8_LDA(At, 0, 0); PG8_STAGE(PG8_SA(1, 1), a1 + hstep, voffA);
            PG8_WAIT_L(8); PG8_BAR; PG8_WAIT_L(0); PG8_MMA(0, 0, At, B0); PG8_BAR; PG8_SCHED;
            PG8_LDB(B1, 0, 1); PG8_STAGE(PG8_SB(0, 0), b2, voffB);
            PG8_BAR; PG8_WAIT_L(0); PG8_MMA(0, 1, At, B1); PG8_BAR;
            PG8_LDA(At, 0, 1); PG8_STAGE(PG8_SA(0, 0), a2, voffA);
            PG8_BAR; PG8_WAIT_L(0); PG8_MMA(1, 0, At, B0); PG8_BAR; PG8_SCHED;
            PG8_STAGE(PG8_SB(0, 1), b2 + hstep, voffB);
            PG8_WAIT_V(6); PG8_BAR; PG8_MMA(1, 1, At, B1); PG8_BAR;
            PG8_LDB(B0, 1, 0); PG8_SCHED; PG8_LDA(At, 1, 0); PG8_STAGE(PG8_SA(0, 1), a2 + hstep, voffA);
            PG8_WAIT_L(8); PG8_BAR; PG8_WAIT_L(0); PG8_MMA(0, 0, At, B0); PG8_BAR; PG8_SCHED;
            PG8_LDB(B1, 1, 1); PG8_STAGE(PG8_SB(1, 0), b3, voffB);
            PG8_BAR; PG8_WAIT_L(0); PG8_MMA(0, 1, At, B1); PG8_BAR;
            PG8_LDA(At, 1, 1); PG8_STAGE(PG8_SA(1, 0), a3, voffA);
            PG8_BAR; PG8_WAIT_L(0); PG8_MMA(1, 0, At, B0); PG8_BAR; PG8_SCHED;
            PG8_STAGE(PG8_SB(1, 1), b3 + hstep, voffB);
            PG8_WAIT_V(6); PG8_BAR; PG8_MMA(1, 1, At, B1); PG8_BAR;
            }
        }
        if constexpr (ALIGN_EPI) { if (wr == 0) PG8_BAR; }
        if constexpr (!Epi::AFTER_DRAIN) { E(acc, cur, wr, wc, fr, fq); S.done(cur); }
        if (!has_next) break;
#pragma unroll
        for (int a = 0; a < 2; ++a)
#pragma unroll
            for (int b = 0; b < 2; ++b)
#pragma unroll
                for (int m = 0; m < 4; ++m)
#pragma unroll
                    for (int n = 0; n < 2; ++n) acc[a][b][m][n] = (f32x4){0.f, 0.f, 0.f, 0.f};
        cur = nxt; cA = nA; cB = nB; ++ui;
        if constexpr (ALIGN_EPI) { if (wr == 1) PG8_BAR; }
    }
    PG8_WAIT_V(0);
    if constexpr (!ALIGN_EPI) { if (wr == 0) PG8_BAR; }
    PG8_BAR;
    if constexpr (Epi::AFTER_DRAIN) { E.fused(acc, cur, wr, wc, fr, fq, lds, wid, lane); S.done(cur); }
#undef PG8_SA
#undef PG8_SB
#undef PG8_STAGE
#undef PG8_LDA
#undef PG8_LDB
#undef PG8_MMA
#undef PG8_WAIT_V
#undef PG8_WAIT_L
#undef PG8_BAR
#undef PG8_SCHED
}
}

constexpr int NWAVES = 8;
constexpr int D = 1024, BATCH = 4, T = 4096, DBATCH = 32, PAST = 8192, PAGE = 128, NPAGES = PAST / PAGE, NPHYS = 2560;
constexpr int HD = 64, NH = 8, FW = 512, DFF = 2816, NMOD = 9, NSEQ = BATCH + DBATCH;
constexpr int M = BATCH * T;
constexpr int MS = M + DBATCH;
constexpr int MP = M + 256;
constexpr int EVEN_IN = 3592, EVEN_PAD = 3840, PROJ_LD = 3584;
constexpr float LN_EPS = 1e-5f, GN_EPS = 1e-6f;
constexpr float ALPHA = 1.4142135623730951f;
constexpr float LOG2E = 1.4426950408889634f;
constexpr float QSCALE = 0.125f * LOG2E;

constexpr size_t O_Y = 0, O_YS = (size_t)M * D, O_KP = O_YS + (size_t)DBATCH * D, O_VP = O_KP + (size_t)M * FW, O_LFP = O_VP + (size_t)M * FW,
    O_SRP = O_LFP + (size_t)M * NH, O_SCP = O_SRP + (size_t)BATCH * NH * HD * HD, O_KS = O_SCP + (size_t)BATCH * 2 * D, O_VS = O_KS + (size_t)DBATCH * FW,
    O_LFS = O_VS + (size_t)DBATCH * FW, O_SRS = O_LFS + (size_t)DBATCH * NH, O_SCS = O_SRS + (size_t)DBATCH * NH * HD * HD, O_END = O_SCS + (size_t)DBATCH * 2 * D;
static_assert(O_END == 35004672, "output size");

constexpr size_t MiB = 1u << 20;
constexpr size_t WS_CTL = 0, CTL_ZERO_BYTES = 1 * MiB;
constexpr size_t WS_MODS = 2 * MiB;
constexpr size_t WS_ROT = 6 * MiB;
constexpr size_t WS_SF = 8 * MiB;
constexpr size_t WS_WFI = 16 * MiB;
constexpr size_t WS_WFO = 64 * MiB;
constexpr size_t WS_WIE = 88 * MiB;
constexpr size_t WS_WOE = 96 * MiB;
constexpr size_t WS_WIO = 98 * MiB;
constexpr size_t WS_WOO = 104 * MiB;
constexpr size_t WS_H = 112 * MiB;
constexpr size_t WS_HID = 148 * MiB;
constexpr size_t WS_PROJ = 240 * MiB;
constexpr size_t WS_AO = 356 * MiB;
constexpr size_t WS_F = 392 * MiB;
constexpr size_t WS_LOGF = 428 * MiB;
constexpr size_t WS_END = 432 * MiB;
static_assert(WS_WFI + 4ull * 5632 * 1024 * 2 <= WS_WFO && WS_WFO + 4ull * 1024 * 2816 * 2 <= WS_WIE && WS_WIE + 3840ull * 1024 * 2 <= WS_WOE && WS_WIO + 3072ull * 1024 * 2 <= WS_WOO, "ws map (weights)");
static_assert(WS_H + (size_t)MP * 1024 * 2 <= WS_HID && WS_HID + (size_t)MP * DFF * 2 <= WS_PROJ && WS_PROJ + (size_t)MP * PROJ_LD * 2 <= WS_AO && WS_AO + (size_t)MP * 1024 * 2 <= WS_F && WS_F + (size_t)M * 1024 * 2 <= WS_LOGF, "ws map");
constexpr int CW_TMO = 0, CW_CODE = 1, CW_BAR = 4096;

constexpr int RING_OFF = 0, RING_BYTES = 131072;
constexpr int LDSCTL_OFF = RING_BYTES, MISC_OFF = LDSCTL_OFF + 320;
constexpr int LDS_BYTES = 147456;

#define GAS __attribute__((address_space(1)))
#define LAS __attribute__((address_space(3)))
typedef unsigned short bf16;
typedef unsigned v4u __attribute__((ext_vector_type(4)));
typedef unsigned v2u __attribute__((ext_vector_type(2)));
typedef float f32x4 __attribute__((ext_vector_type(4)));
typedef float f32x16 __attribute__((ext_vector_type(16)));
typedef short bf16x8 __attribute__((ext_vector_type(8)));
typedef short s16x4 __attribute__((ext_vector_type(4)));
typedef GAS unsigned gu32;
#define RLX_AGENT __ATOMIC_RELAXED, __HIP_MEMORY_SCOPE_AGENT
#define LDS_WAIT() asm volatile("s_waitcnt lgkmcnt(0)" ::: "memory")
#define VM_WAIT() asm volatile("s_waitcnt vmcnt(0)" ::: "memory")
#define LBAR() asm volatile("s_waitcnt lgkmcnt(0)\n\ts_barrier" ::: "memory")
__device__ __forceinline__ unsigned f2bf(float f) { unsigned u = __builtin_bit_cast(unsigned, f); return (u + 0x7fffu + ((u >> 16) & 1u)) >> 16; }
__device__ __forceinline__ unsigned pk2(float lo, float hi) { return f2bf(lo) | (f2bf(hi) << 16); }
__device__ __forceinline__ float bf2f(unsigned short b) { return __builtin_bit_cast(float, (unsigned)b << 16); }
__device__ __forceinline__ float bflo(unsigned w) { return __builtin_bit_cast(float, w << 16); }
__device__ __forceinline__ float bfhi(unsigned w) { return __builtin_bit_cast(float, w & 0xffff0000u); }
__device__ __forceinline__ float wave_sum(float v) {
#pragma unroll
    for (int o = 1; o < 64; o <<= 1) v += __shfl_xor(v, o);
    return v;
}
__device__ __forceinline__ float ex2(float x) { return __builtin_amdgcn_exp2f(x); }
__device__ __forceinline__ int crow(int r, int hi) { return (r & 3) + 8 * (r >> 2) + 4 * hi; }
#define MFMA32(a, b, c) __builtin_amdgcn_mfma_f32_32x32x16_bf16((a), (b), (c), 0, 0, 0)
typedef short v4i16_t __attribute__((ext_vector_type(4)));
__device__ __forceinline__ s16x4 vtr(const LAS unsigned char* p) { return __builtin_bit_cast(s16x4, __builtin_amdgcn_ds_read_tr16_b64_v4i16((LAS v4i16_t*)p)); }
__device__ __forceinline__ bf16x8 cat8(s16x4 lo, s16x4 hi) { return (bf16x8){lo[0], lo[1], lo[2], lo[3], hi[0], hi[1], hi[2], hi[3]}; }
#define XB_TMO      128
#define XB_XCNT(j)  (256  + 64 * (j))
#define XB_XSUB(j)  (1280 + 64 * (j))
#define XB_XGEN(j)  (2304 + 64 * (j))
#define XB_TOP      3328
#define XB_TOPGEN   3392
#define XCD_BAR_WORDS 3456
#define XB_SPIN_CAP (1u << 18)

__device__ __forceinline__ unsigned xb_ld(unsigned* p)              { return __hip_atomic_load(p, __ATOMIC_RELAXED, __HIP_MEMORY_SCOPE_AGENT); }
__device__ __forceinline__ unsigned xb_add(unsigned* p, unsigned v) { return __hip_atomic_fetch_add(p, v, __ATOMIC_RELAXED, __HIP_MEMORY_SCOPE_AGENT); }
__device__ __forceinline__ unsigned xb_xcc_id() { return (unsigned)__builtin_amdgcn_s_getreg((3 << 11) | 20) & 0xFu; }
#define XB_SPIN(cond, bar) do { unsigned _sp = 0; while (cond) { __builtin_amdgcn_s_sleep(1); \
    if ((++_sp & 255u) == 0u) { if (xb_ld(&(bar)[XB_TMO])) break; if (_sp > XB_SPIN_CAP) { atomicAdd(&(bar)[XB_TMO], 1u); break; } } } } while (0)

struct XcdBarrier {
    unsigned* bar; unsigned x;
    volatile LAS unsigned* st;
};

__device__ __forceinline__ XcdBarrier xcd_barrier_post(unsigned* bar, volatile LAS unsigned* st) {
    XcdBarrier b; b.bar = bar; b.x = xb_xcc_id(); b.st = st;
    if (threadIdx.x == 0) (void)xb_add(&bar[XB_XCNT(b.x)], 1u);
    return b;
}
__device__ __forceinline__ void xcd_barrier_complete(unsigned* bar, unsigned x, unsigned& nloc, unsigned& nx) {
    const unsigned G = gridDim.x * gridDim.y * gridDim.z;
    unsigned sum, cnt, mine, sp = 0u;
    for (;;) {
        sum = 0u; cnt = 0u; mine = 0u;
#pragma unroll
        for (unsigned j = 0; j < 16; ++j) { const unsigned c = xb_ld(&bar[XB_XCNT(j)]); sum += c; cnt += (c > 0u) ? 1u : 0u; mine = (j == x) ? c : mine; }
        if (sum == G) break;
        __builtin_amdgcn_s_sleep(1);
        if ((++sp & 255u) == 0u) { if (xb_ld(&bar[XB_TMO])) break; if (sp > XB_SPIN_CAP) { atomicAdd(&bar[XB_TMO], 1u); break; } }
    }
    nloc = mine > 0u ? mine : 1u; nx = cnt > 0u ? cnt : 1u;
}

__device__ __forceinline__ void xcd_barrier(const XcdBarrier& b) {
    asm volatile("s_waitcnt vmcnt(0)" ::: "memory");
    __syncthreads();
    if (threadIdx.x == 0) {
        unsigned* bar = b.bar;
        __builtin_amdgcn_s_waitcnt(0);
        unsigned nloc = b.st[0], nx = b.st[1];
        if (nloc == 0u) { xcd_barrier_complete(bar, b.x, nloc, nx); b.st[0] = nloc; b.st[1] = nx; }
        const unsigned old = xb_add(&bar[XB_XSUB(b.x)], 1u);
        const unsigned gen = old / nloc;
        if (old + 1u == (gen + 1u) * nloc) {
            __builtin_amdgcn_fence(__ATOMIC_RELEASE, "agent");
            asm volatile("s_waitcnt vmcnt(0)" ::: "memory");
            const unsigned og = xb_add(&bar[XB_TOP], 1u);
            const unsigned tg = og / nx;
            if (og + 1u == (tg + 1u) * nx) xb_add(&bar[XB_TOPGEN], 1u);
            else XB_SPIN(xb_ld(&bar[XB_TOPGEN]) == tg, bar);
            __builtin_amdgcn_fence(__ATOMIC_ACQUIRE, "agent");
            xb_add(&bar[XB_XGEN(b.x)], 1u);
            asm volatile("s_waitcnt vmcnt(0)" ::: "memory");
        } else {
            XB_SPIN(xb_ld(&bar[XB_XGEN(b.x)]) == gen, bar);
            __builtin_amdgcn_fence(__ATOMIC_ACQUIRE, "agent");
            asm volatile("s_waitcnt vmcnt(0)" ::: "memory");
        }
    }
    __syncthreads();
}

struct Frame {
    LAS unsigned char* lds;
    volatile LAS unsigned* MISC;
    gu32* ctl;
    int tid, lane, wave, vcu, G;
    const float* in[22];
    float* out; unsigned char* ws;
};
#define IN_X 0
#define IN_XS 1
#define IN_CK 2
#define IN_CV 3
#define IN_CLF 4
#define IN_SRET 5
#define IN_SCONV 6
#define IN_PT 7
#define IN_CP 8
#define IN_CS 9
#define IN_WADA 10
#define IN_BADA 11
#define IN_WFI 12
#define IN_WFO 13
#define IN_LNG 14
#define IN_LNB 15
#define IN_WIE 16
#define IN_BF 17
#define IN_WOE 18
#define IN_WIO 19
#define IN_CW 20
#define IN_WOO 21

__device__ __forceinline__ void refresh(Frame& F) { int t = F.tid; asm volatile("" : "+v"(t)); F.tid = t; F.lane = t & 63; F.wave = __builtin_amdgcn_readfirstlane(t >> 6); }
__device__ __forceinline__ int seq_of(int r) { return r < M ? (r >> 12) : (BATCH + r - M); }
__device__ __forceinline__ const float* mods_ptr(const Frame& F, int l, int s, int chunk) { return (const float*)(F.ws + WS_MODS) + ((size_t)(l * NSEQ + s) * NMOD + chunk) * D; }

__device__ __forceinline__ void p0_block(const float* W, int K, int N, int k0, int n0, bf16* dst, LAS float* scr, int lane) {
#pragma unroll 8
    for (int i = 0; i < 32; ++i) { const int kk = 2 * i + (lane >> 5); scr[kk * 33 + (lane & 31)] = W[(size_t)(k0 + kk) * N + n0 + (lane & 31)]; }
    LDS_WAIT(); asm volatile("" ::: "memory");
    const int c = lane & 7;
#pragma unroll
    for (int j = 0; j < 4; ++j) { const int n = (lane >> 3) + 8 * j; const LAS float* s = scr + (8 * c) * 33 + n;
        v4u o; o.x = pk2(s[0 * 33], s[1 * 33]); o.y = pk2(s[2 * 33], s[3 * 33]); o.z = pk2(s[4 * 33], s[5 * 33]); o.w = pk2(s[6 * 33], s[7 * 33]);
        *(GAS v4u*)(dst + (size_t)n * K + k0 + 8 * c) = o; }
    LDS_WAIT(); asm volatile("" ::: "memory");
}
__device__ __forceinline__ int pair_row(int n0, int half_off) { return 256 * (n0 >> 7) + half_off + (n0 & 127); }

__device__ __forceinline__ void mods_unit(Frame& F, int u) {
    refresh(F);
    const int l = u / 144, c0 = 64 * (u % 144);
    const float* W = F.in[IN_WADA] + (size_t)l * D * (NMOD * D) + c0 + F.lane;
    const float* cp = F.in[IN_CP]; const float* cs = F.in[IN_CS];
    LAS float* tab = (LAS float*)F.lds;
    float acc[NSEQ];
#pragma unroll
    for (int s = 0; s < NSEQ; ++s) acc[s] = 0.f;
    for (int half = 0; half < 2; ++half) {
        __syncthreads();
        for (int s = 0; s < NSEQ; ++s) { const float cv = s < BATCH ? cp[s * D + 512 * half + F.tid] : cs[(s - BATCH) * D + 512 * half + F.tid]; tab[s * 512 + F.tid] = cv / (1.0f + __expf(-cv)); }
        __syncthreads();
        const int kb = 64 * F.wave;
#pragma unroll 2
        for (int k4 = 0; k4 < 16; ++k4) { const int kk = kb + 4 * k4; const float* wp = W + (size_t)(512 * half + kk) * (NMOD * D);
            const float w0 = wp[0], w1 = wp[NMOD * D], w2 = wp[2 * NMOD * D], w3 = wp[3 * NMOD * D];
#pragma unroll
            for (int s = 0; s < NSEQ; ++s) { const f32x4 c4 = *(const LAS f32x4*)(tab + s * 512 + kk); acc[s] += (w0 * c4.x + w1 * c4.y) + (w2 * c4.z + w3 * c4.w); } }
    }
    __syncthreads();
    LAS float* red = (LAS float*)F.lds;
#pragma unroll
    for (int s = 0; s < NSEQ; ++s) red[(F.wave * NSEQ + s) * 64 + F.lane] = acc[s];
    __syncthreads();
    float* mods = (float*)(F.ws + WS_MODS);
    for (int o = F.tid; o < NSEQ * 64; o += NWAVES * 64) { const int s = o >> 6, c = o & 63; float v = F.in[IN_BADA][l * NMOD * D + c0 + c];
#pragma unroll
        for (int w = 0; w < NWAVES; ++w) v += red[(w * NSEQ + s) * 64 + c];
        mods[(size_t)(l * NSEQ + s) * (NMOD * D) + c0 + c] = v; }
    __syncthreads();
}

__device__ __forceinline__ void p0_prologue(Frame& F) {
    for (int u = F.vcu; u < 288; u += F.G) mods_unit(F, u);
    LAS float* scr = (LAS float*)(F.lds + RING_OFF + F.wave * 16384);
    const int gw = F.vcu * NWAVES + F.wave, NGW = F.G * NWAVES;
    constexpr int I_FI = 16 * 176, I_FO = 44 * 32, I_IE = 16 * 112, I_SQ = 16 * 32, I_IO = 16 * 96;
    constexpr int NITEMS = 4 * I_FI + 4 * I_FO + I_IE + I_SQ + I_IO + I_SQ;
    for (int it = gw; it < NITEMS; it += NGW) {
        int r = it;
        if (r < 4 * I_FI) { const int mi = r / I_FI; r -= mi * I_FI; const int kb = r / 176, nb = r % 176, n0 = 32 * nb;
            const int drow = n0 < DFF ? pair_row(n0, 0) : pair_row(n0 - DFF, 128);
            p0_block(F.in[IN_WFI] + (size_t)mi * D * 2 * DFF, D, 2 * DFF, 64 * kb, n0, (bf16*)(F.ws + WS_WFI) + (size_t)mi * 2 * DFF * D + (size_t)drow * D, scr, F.lane); continue; }
        r -= 4 * I_FI;
        if (r < 4 * I_FO) { const int mi = r / I_FO; r -= mi * I_FO; const int kb = r / 32, nb = r % 32;
            p0_block(F.in[IN_WFO] + (size_t)mi * DFF * D, DFF, D, 64 * kb, 32 * nb, (bf16*)(F.ws + WS_WFO) + (size_t)mi * D * DFF + (size_t)(32 * nb) * DFF, scr, F.lane); continue; }
        r -= 4 * I_FO;
        if (r < I_IE) { const int kb = r / 112, nb = r % 112; const int n0 = nb < 48 ? 32 * nb : 1544 + 32 * (nb - 48), drow = nb < 48 ? 32 * nb : 1536 + 32 * (nb - 48);
            p0_block(F.in[IN_WIE], D, EVEN_IN, 64 * kb, n0, (bf16*)(F.ws + WS_WIE) + (size_t)drow * D, scr, F.lane); continue; }
        r -= I_IE;
        if (r < I_SQ) { const int kb = r / 32, nb = r % 32; p0_block(F.in[IN_WOE], D, D, 64 * kb, 32 * nb, (bf16*)(F.ws + WS_WOE) + (size_t)(32 * nb) * D, scr, F.lane); continue; }
        r -= I_SQ;
        if (r < I_IO) { const int kb = r / 96, nb = r % 96, n0 = 32 * nb;
            const int drow = n0 < 1024 ? 2048 + n0 : (n0 < 2048 ? pair_row(n0 - 1024, 0) : pair_row(n0 - 2048, 128));
            p0_block(F.in[IN_WIO], D, 3 * D, 64 * kb, n0, (bf16*)(F.ws + WS_WIO) + (size_t)drow * D, scr, F.lane); continue; }
        r -= I_IO;
        { const int kb = r / 32, nb = r % 32; p0_block(F.in[IN_WOO], D, D, 64 * kb, 32 * nb, (bf16*)(F.ws + WS_WOO) + (size_t)(32 * nb) * D, scr, F.lane); }
    }
    const int gt = F.vcu * (NWAVES * 64) + F.tid, NGT = F.G * NWAVES * 64;
    for (int i = gt; i < 256 * 128; i += NGT) { const int row = 3584 + (i >> 7), k8 = (i & 127) * 8; v4u o = {0u, 0u, 0u, 0u};
        if (row < 3592) { const float* w = F.in[IN_WIE] + (size_t)k8 * EVEN_IN + 1536 + (row - 3584);
            o.x = pk2(w[0], w[EVEN_IN]); o.y = pk2(w[2 * EVEN_IN], w[3 * EVEN_IN]); o.z = pk2(w[4 * EVEN_IN], w[5 * EVEN_IN]); o.w = pk2(w[6 * EVEN_IN], w[7 * EVEN_IN]); }
        *(GAS v4u*)((bf16*)(F.ws + WS_WIE) + (size_t)row * D + k8) = o; }
    for (int i = gt; i < (MP - MS) * 128; i += NGT) *(GAS v4u*)((bf16*)(F.ws + WS_H) + (size_t)MS * D + (size_t)i * 8) = (v4u){0u, 0u, 0u, 0u};
    for (int i = gt; i < 4097 * 32; i += NGT) { const int p = i >> 5, fi = i & 31; const float pos = p < 4096 ? (float)p : 8192.0f;
        const float inv = 1.0f / powf(10000.0f, (float)fi * (1.0f / 31.0f)); const float ang = pos * inv;
        double rev = (double)ang * 0.15915494309189535; rev -= floor(rev); const float rf = (float)rev;
        float* o = (float*)(F.ws + WS_ROT) + (size_t)i * 2; o[0] = __builtin_amdgcn_cosf(rf); o[1] = __builtin_amdgcn_sinf(rf); }
}

__device__ __forceinline__ void modulate_phase(Frame& F) {
    const int gw = F.vcu * NWAVES + F.wave, NGW = F.G * NWAVES;
    for (int r = gw; r < MS; r += NGW) {
        const float* x = r < M ? F.in[IN_X] + (size_t)r * D : F.in[IN_XS] + (size_t)(r - M) * D; const int s = seq_of(r);
        const float* sh = mods_ptr(F, 0, s, 0); const float* sc = mods_ptr(F, 0, s, 1);
        bf16* h = (bf16*)(F.ws + WS_H) + (size_t)r * D;
#pragma unroll
        for (int j = 0; j < 4; ++j) { const int c = 4 * F.lane + 256 * j; const f32x4 xv = *(const f32x4*)(x + c), a = *(const f32x4*)(sh + c), b = *(const f32x4*)(sc + c);
            const f32x4 y = xv * (b + 1.0f) + a; v2u o; o.x = pk2(y.x, y.y); o.y = pk2(y.z, y.w); *(GAS v2u*)(h + c) = o; }
    }
}
__device__ __forceinline__ void ln_phase(Frame& F, int l, int j, bool first, bool last, int nl, int nj) {
    const int gw = F.vcu * NWAVES + F.wave, NGW = F.G * NWAVES;
    const float gs = (j == 1) ? 1.0f : 0.5f;
    const float* lng = F.in[IN_LNG] + (size_t)(l * 3 + j) * D; const float* lnb = F.in[IN_LNB] + (size_t)(l * 3 + j) * D;
    for (int r = gw; r < MS; r += NGW) {
        const int s = seq_of(r);
        const float* x = first ? (r < M ? F.in[IN_X] + (size_t)r * D : F.in[IN_XS] + (size_t)(r - M) * D) : F.out + (size_t)r * D;
        const float* g = mods_ptr(F, l, s, 3 * j + 2);
        f32x4 v[4]; float sum = 0.f;
#pragma unroll
        for (int q = 0; q < 4; ++q) { const int c = 4 * F.lane + 256 * q; const f32x4 xv = *(const f32x4*)(x + c), gv = *(const f32x4*)(g + c); f32x4 fv;
            if (r < M) { const v2u fw = *(const GAS v2u*)((const bf16*)(F.ws + WS_F) + (size_t)r * D + c); fv = (f32x4){bflo(fw.x), bfhi(fw.x), bflo(fw.y), bfhi(fw.y)}; }
            else fv = *(const f32x4*)((const float*)(F.ws + WS_SF) + (size_t)(r - M) * D + c);
            v[q] = xv * ALPHA + gv * fv * gs; sum += (v[q].x + v[q].y) + (v[q].z + v[q].w); }
        const float mean = wave_sum(sum) * (1.0f / D); float s2 = 0.f;
#pragma unroll
        for (int q = 0; q < 4; ++q) { v[q] = v[q] - mean; s2 += (v[q].x * v[q].x + v[q].y * v[q].y) + (v[q].z * v[q].z + v[q].w * v[q].w); }
        const float rstd = 1.0f / sqrtf(wave_sum(s2) * (1.0f / D) + LN_EPS);
        float* xo = F.out + (size_t)r * D; bf16* h = (bf16*)(F.ws + WS_H) + (size_t)r * D;
        const float* sh = last ? lng : mods_ptr(F, nl, s, 3 * nj); const float* sc = last ? lng : mods_ptr(F, nl, s, 3 * nj + 1);
#pragma unroll
        for (int q = 0; q < 4; ++q) { const int c = 4 * F.lane + 256 * q; const f32x4 y = v[q] * rstd * *(const f32x4*)(lng + c) + *(const f32x4*)(lnb + c);
            *(f32x4*)(xo + c) = y;
            if (!last) { const f32x4 hv = y * (*(const f32x4*)(sc + c) + 1.0f) + *(const f32x4*)(sh + c); v2u o; o.x = pk2(hv.x, hv.y); o.y = pk2(hv.z, hv.w); *(GAS v2u*)(h + c) = o; } }
    }
}
__device__ __forceinline__ void conv_phase(Frame& F) {
    const int gw = F.vcu * NWAVES + F.wave, NGW = F.G * NWAVES;
    const bf16* UP = (const bf16*)(F.ws + WS_PROJ); const bf16* BG = (const bf16*)(F.ws + WS_PROJ + 64 * MiB); bf16* AO = (bf16*)(F.ws + WS_AO);
    const float* cw = F.in[IN_CW];
    for (int r = gw; r < MS; r += NGW) {
#pragma unroll
        for (int q = 0; q < 2; ++q) { const int c = 8 * F.lane + 512 * q;
            float w0[8], w1[8], w2[8], z[8];
#pragma unroll
            for (int e = 0; e < 8; ++e) { w0[e] = cw[c + e]; w1[e] = cw[D + c + e]; w2[e] = cw[2 * D + c + e]; }
            const v4u bg = *(const GAS v4u*)(BG + (size_t)r * D + c);
            if (r < M) { const int t = r & 4095; const v4u u0 = *(const GAS v4u*)(UP + (size_t)r * D + c);
                v4u u1 = {0u, 0u, 0u, 0u}, u2 = {0u, 0u, 0u, 0u};
                if (t >= 1) u1 = *(const GAS v4u*)(UP + (size_t)(r - 1) * D + c);
                if (t >= 2) u2 = *(const GAS v4u*)(UP + (size_t)(r - 2) * D + c);
#pragma unroll
                for (int e = 0; e < 4; ++e) { z[2 * e] = w2[2 * e] * bflo(u0[e]) + w1[2 * e] * bflo(u1[e]) + w0[2 * e] * bflo(u2[e]); z[2 * e + 1] = w2[2 * e + 1] * bfhi(u0[e]) + w1[2 * e + 1] * bfhi(u1[e]) + w0[2 * e + 1] * bfhi(u2[e]); }
            } else { const int b = r - M; const float* b0 = F.in[IN_SCONV] + (size_t)(b * 2) * D + c; const float* b1 = b0 + D; float* so = F.out + O_SCS + (size_t)(b * 2) * D + c;
#pragma unroll
                for (int e = 0; e < 8; ++e) { z[e] = w0[e] * b0[e] + w1[e] * b1[e] + w2[e] * so[D + e]; so[e] = b1[e]; } }
            v4u o;
#pragma unroll
            for (int e = 0; e < 4; ++e) o[e] = pk2(z[2 * e] * bflo(bg[e]), z[2 * e + 1] * bfhi(bg[e]));
            *(GAS v4u*)(AO + (size_t)r * D + c) = o; }
    }
}

__device__ __forceinline__ void small_gemm32(Frame& F, const bf16* As, const bf16* Bt, int K, int ct) {
    const int r32 = F.lane & 31, hi = F.lane >> 5; const int kper = K >> 3, steps = kper >> 4;
    const bf16* ap = As + (size_t)r32 * K + F.wave * kper + 8 * hi; const bf16* bp = Bt + (size_t)(32 * ct + r32) * K + F.wave * kper + 8 * hi;
    f32x16 acc;
#pragma unroll
    for (int i = 0; i < 16; ++i) acc[i] = 0.f;
#pragma unroll 2
    for (int s = 0; s < steps; ++s) { const bf16x8 a = *(const GAS bf16x8*)(ap + 16 * s), b = *(const GAS bf16x8*)(bp + 16 * s); acc = MFMA32(a, b, acc); }
    LAS float* red = (LAS float*)F.lds;
#pragma unroll
    for (int i = 0; i < 16; ++i) red[(F.wave * 16 + i) * 64 + F.lane] = acc[i];
    __syncthreads();
    float* SF = (float*)(F.ws + WS_SF);
    for (int o = F.tid; o < 1024; o += NWAVES * 64) { const int i = o >> 6, ln = o & 63; float v = 0.f;
#pragma unroll
        for (int w = 0; w < NWAVES; ++w) v += red[(w * 16 + i) * 64 + ln];
        SF[(size_t)crow(i, ln >> 5) * D + 32 * ct + (ln & 31)] = v; }
    __syncthreads();
}

__device__ __forceinline__ float block_incl_scan(Frame& F, float v, LAS float* scr) {
    float x = v;
#pragma unroll
    for (int o = 1; o < 64; o <<= 1) { const float y = __shfl_up(x, o); if (F.lane >= o) x += y; }
    if (F.lane == 63) scr[F.wave] = x;
    __syncthreads();
    float pre = 0.f;
#pragma unroll
    for (int w = 0; w < NWAVES; ++w) { const float t = scr[w]; if (w < F.wave) pre += t; }
    __syncthreads();
    return x + pre;
}

constexpr int AT_C2 = 0, AT_K = 16384, AT_V = 32768, AT_WSF = 49152, AT_OST = 51200, AT_SCAN = 83968;
__device__ __forceinline__ void fox_unit(Frame& F, int b, int h, int qb) {
    refresh(F);
    const int lane = F.lane, r32 = lane & 31, hi = lane >> 5, wid = F.wave, tid = F.tid;
    LAS unsigned char* lds = F.lds;
    LAS float* c2 = (LAS float*)(lds + AT_C2);
    const bf16* Pb = (const bf16*)(F.ws + WS_PROJ) + (size_t)b * T * PROJ_LD;
    const float* lf = (const float*)(F.ws + WS_LOGF) + (size_t)b * T * NH + h;
    const int nkeys = 256 * (qb + 1);
    __syncthreads();
    { float v[8]; float tot = 0.f;
#pragma unroll
      for (int e = 0; e < 8; ++e) { const int t = 8 * tid + e; v[e] = t < nkeys ? lf[(size_t)t * NH] * LOG2E : 0.f; tot += v[e]; }
      const float incl = block_incl_scan(F, tot, (LAS float*)(lds + AT_SCAN)); float run = incl - tot;
      if (8 * tid < nkeys) {
#pragma unroll
        for (int e = 0; e < 8; ++e) { run += v[e]; c2[8 * tid + e] = run; } }
    }
    const int q0w = 256 * qb + 32 * wid;
    const bf16* Qw = Pb + (size_t)(q0w + r32) * PROJ_LD + h * HD;
    bf16x8 qr[4];
#pragma unroll
    for (int d0 = 0; d0 < 4; ++d0) qr[d0] = *(const GAS bf16x8*)(Qw + d0 * 16 + hi * 8);
    const bf16* Kh = Pb + FW + h * HD; const bf16* Vh = Pb + 2 * FW + h * HD;
    const bf16* ksrc = Kh + (size_t)lane * PROJ_LD + wid * 8;
    const bf16* vsrc = Vh + (size_t)(16 * (wid & 3) + (lane >> 2)) * PROJ_LD + (wid >> 2) * 32 + (lane & 3) * 8;
    const int NT = 4 * qb + 4;
    v4u kreg = *(const GAS v4u*)ksrc, vreg = *(const GAS v4u*)vsrc;
    const int stoff = wid * 1024 + lane * 16;
    *(LAS v4u*)(lds + AT_K + stoff) = kreg; *(LAS v4u*)(lds + AT_V + stoff) = vreg;
    if (NT > 1) { kreg = *(const GAS v4u*)(ksrc + (size_t)64 * PROJ_LD); vreg = *(const GAS v4u*)(vsrc + (size_t)64 * PROJ_LD); }
    __syncthreads();
    const float cq2 = c2[q0w + r32];
    float m_run = -INFINITY, l_run = 0.f;
    f32x16 o0, o1;
#pragma unroll
    for (int i = 0; i < 16; ++i) { o0[i] = 0.f; o1[i] = 0.f; }
    LAS float* wsf = (LAS float*)(lds + AT_WSF) + wid * 64;
    const int kfo = hi * 1024 + r32 * 16;
    const int vfo = ((lane >> 4) & 1) * 32 + (lane & 3) * 8 + (4 * hi + ((lane & 15) >> 2)) * 64;
    for (int t = 0; t < NT; ++t) {
        const int cur = (t & 1) * 8192, nxt = 8192 - cur;
        if (t + 1 < NT) { *(LAS v4u*)(lds + AT_K + nxt + stoff) = kreg; *(LAS v4u*)(lds + AT_V + nxt + stoff) = vreg; }
        if (t + 2 < NT) { kreg = *(const GAS v4u*)(ksrc + (size_t)(t + 2) * 64 * PROJ_LD); vreg = *(const GAS v4u*)(vsrc + (size_t)(t + 2) * 64 * PROJ_LD); }
        if (64 * t <= q0w + 31) {
            f32x16 p0, p1;
#pragma unroll
            for (int g = 0; g < 4; ++g) { const f32x4 ca = *(const LAS f32x4*)(c2 + 64 * t + 8 * g + 4 * hi), cb = *(const LAS f32x4*)(c2 + 64 * t + 32 + 8 * g + 4 * hi);
#pragma unroll
                for (int e = 0; e < 4; ++e) { p0[4 * g + e] = cq2 - ca[e]; p1[4 * g + e] = cq2 - cb[e]; } }
            const LAS unsigned char* kp = lds + AT_K + cur + kfo;
#pragma unroll
            for (int d0 = 0; d0 < 4; ++d0) { const bf16x8 k0 = *(const LAS bf16x8*)(kp + d0 * 2048), k1 = *(const LAS bf16x8*)(kp + d0 * 2048 + 512);
                p0 = MFMA32(k0, qr[d0], p0); p1 = MFMA32(k1, qr[d0], p1); }
            if (64 * t + 63 > q0w) { const int q = q0w + r32;
#pragma unroll
                for (int i = 0; i < 16; ++i) { const int key = 64 * t + crow(i, hi); if (key > q) p0[i] = -INFINITY; if (key + 32 > q) p1[i] = -INFINITY; } }
            float mx = fmaxf(p0[0], p1[0]);
#pragma unroll
            for (int i = 1; i < 16; ++i) mx = fmaxf(mx, fmaxf(p0[i], p1[i]));
            mx = fmaxf(mx, __shfl_xor(mx, 32));
            const float m_new = fmaxf(m_run, mx); const float alpha = ex2(m_run - m_new); m_run = m_new;
            float ps = 0.f;
#pragma unroll
            for (int i = 0; i < 16; ++i) { p0[i] = ex2(p0[i] - m_new); p1[i] = ex2(p1[i] - m_new); ps += p0[i] + p1[i]; }
            l_run = l_run * alpha + ps;
            if (__any(alpha != 1.0f)) {
                if (hi == 0) wsf[r32] = alpha;
                LDS_WAIT();
#pragma unroll
                for (int i = 0; i < 16; ++i) { const float a = wsf[crow(i, hi)]; o0[i] *= a; o1[i] *= a; }
            }
            bf16x8 pa[4];
#pragma unroll
            for (int s = 0; s < 2; ++s) { v4u w0, w1;
#pragma unroll
                for (int e = 0; e < 4; ++e) { w0[e] = pk2(p0[8 * s + 2 * e], p0[8 * s + 2 * e + 1]); w1[e] = pk2(p1[8 * s + 2 * e], p1[8 * s + 2 * e + 1]); }
                pa[s] = __builtin_bit_cast(bf16x8, w0); pa[2 + s] = __builtin_bit_cast(bf16x8, w1); }
            const LAS unsigned char* vp = lds + AT_V + cur + vfo;
#pragma unroll
            for (int ks = 0; ks < 4; ++ks) {
                const bf16x8 va = cat8(vtr(vp + ks * 1024), vtr(vp + ks * 1024 + 512));
                const bf16x8 vb = cat8(vtr(vp + 4096 + ks * 1024), vtr(vp + 4096 + ks * 1024 + 512));
                o0 = MFMA32(pa[ks], va, o0); o1 = MFMA32(pa[ks], vb, o1); }
        }
        LBAR();
    }
    l_run += __shfl_xor(l_run, 32);
    if (hi == 0) wsf[32 + r32] = 1.0f / l_run;
    LDS_WAIT();
    bf16* Ow = (bf16*)(F.ws + WS_AO) + (size_t)(b * T + q0w) * D + h * HD;
    LAS bf16* stg = (LAS bf16*)(lds + AT_OST) + wid * 2048;
#pragma unroll
    for (int i = 0; i < 16; ++i) { const int orow = crow(i, hi); const float il = wsf[32 + orow];
        stg[orow * 64 + r32] = (bf16)f2bf(o0[i] * il); stg[orow * 64 + 32 + r32] = (bf16)f2bf(o1[i] * il); }
    LDS_WAIT();
#pragma unroll
    for (int i = 0; i < 4; ++i) { const int row = i * 8 + (lane >> 3), ch = lane & 7; const v4u v = *(const LAS v4u*)(stg + row * 64 + ch * 8); *(GAS v4u*)(Ow + (size_t)row * D + ch * 8) = v; }
}

constexpr int DC_D2 = 0, DC_MRG = 32768, DC_SCAN = 32768 + 33 * 68 * 4;
__device__ __forceinline__ void decode_unit(Frame& F, int b, int h) {
    refresh(F);
    const int lane = F.lane, wid = F.wave, tid = F.tid;
    LAS unsigned char* lds = F.lds;
    LAS float* d2 = (LAS float*)(lds + DC_D2);
    const int* pt = (const int*)F.in[IN_PT] + b * NPAGES;
    const float* clf = F.in[IN_CLF];
    const float lf_new = ((const float*)(F.ws + WS_LOGF))[(size_t)(M + b) * NH + h] * LOG2E;
    __syncthreads();
    { float v[16]; float tot = 0.f; const int j0 = 16 * tid; const int page = pt[j0 >> 7];
      const float* src = clf + ((size_t)page * PAGE + (j0 & 127)) * NH + h;
#pragma unroll
      for (int e = 0; e < 16; ++e) { v[e] = src[(size_t)e * NH] * LOG2E; tot += v[e]; }
      const float incl = block_incl_scan(F, tot, (LAS float*)(lds + DC_SCAN));
      LAS float* gt = (LAS float*)(lds + DC_SCAN) + 16;
      if (tid == NWAVES * 64 - 1) gt[0] = incl;
      __syncthreads();
      float run = (gt[0] - incl) + lf_new;
#pragma unroll
      for (int e = 15; e >= 0; --e) { d2[j0 + e] = run; run += v[e]; }
    }
    __syncthreads();
    const int sub = lane >> 4, c = lane & 15;
    const bf16* qrow = (const bf16*)(F.ws + WS_PROJ) + (size_t)(M + b) * PROJ_LD + h * HD + 4 * c;
    const v2u qw = *(const GAS v2u*)qrow;
    const float q0 = bflo(qw.x), q1 = bfhi(qw.x), q2 = bflo(qw.y), q3 = bfhi(qw.y);
    const float* ck = F.in[IN_CK]; const float* cv = F.in[IN_CV];
    float m_run = -INFINITY, l_run = 0.f; f32x4 acc = {0.f, 0.f, 0.f, 0.f};
    for (int pg = 0; pg < 8; ++pg) {
        const int page = pt[8 * wid + pg];
        const size_t pbase = ((size_t)page * PAGE * NH + h) * HD + 4 * c;
        const int jb = 1024 * wid + 128 * pg;
#pragma unroll 2
        for (int it = 0; it < 8; ++it) {
            f32x4 kv[4], vv[4];
#pragma unroll
            for (int u = 0; u < 4; ++u) { const size_t off = pbase + (size_t)(16 * it + 4 * u + sub) * (NH * HD);
                kv[u] = __builtin_nontemporal_load((const f32x4*)(ck + off)); vv[u] = __builtin_nontemporal_load((const f32x4*)(cv + off)); }
#pragma unroll
            for (int u = 0; u < 4; ++u) {
                float s = (kv[u].x * q0 + kv[u].y * q1) + (kv[u].z * q2 + kv[u].w * q3);
                s += __shfl_xor(s, 1); s += __shfl_xor(s, 2); s += __shfl_xor(s, 4); s += __shfl_xor(s, 8);
                s += d2[jb + 16 * it + 4 * u + sub];
                const float m_new = fmaxf(m_run, s); const float alpha = ex2(m_run - m_new), p = ex2(s - m_new); m_run = m_new;
                l_run = l_run * alpha + p; acc = acc * alpha + vv[u] * p;
            }
        }
    }
    LAS float* mrg = (LAS float*)(lds + DC_MRG);
    { LAS float* rec = mrg + (wid * 4 + sub) * 68; if (c == 0) { rec[0] = m_run; rec[1] = l_run; } *(LAS f32x4*)(rec + 4 + 4 * c) = acc; }
    if (wid == 0 && sub == 0) {
        const bf16* krow = (const bf16*)(F.ws + WS_PROJ) + (size_t)(M + b) * PROJ_LD + FW + h * HD + 4 * c; const bf16* vrow = krow + FW;
        const v2u kw = *(const GAS v2u*)krow, vw = *(const GAS v2u*)vrow;
        float s = (bflo(kw.x) * q0 + bfhi(kw.x) * q1) + (bflo(kw.y) * q2 + bfhi(kw.y) * q3);
        s += __shfl_xor(s, 1); s += __shfl_xor(s, 2); s += __shfl_xor(s, 4); s += __shfl_xor(s, 8);
        LAS float* rec = mrg + 32 * 68; if (c == 0) { rec[0] = s; rec[1] = 1.0f; } *(LAS f32x4*)(rec + 4 + 4 * c) = (f32x4){bflo(vw.x), bfhi(vw.x), bflo(vw.y), bfhi(vw.y)};
    }
    __syncthreads();
    if (tid < 64) { float mm = -INFINITY;
        for (int p = 0; p < 33; ++p) mm = fmaxf(mm, mrg[p * 68]);
        float L = 0.f, o = 0.f;
        for (int p = 0; p < 33; ++p) { const float w = ex2(mrg[p * 68] - mm); L += mrg[p * 68 + 1] * w; o += mrg[p * 68 + 4 + tid] * w; }
        ((bf16*)(F.ws + WS_AO))[(size_t)(M + b) * D + h * HD + tid] = (bf16)f2bf(o / L); }
}

__device__ __forceinline__ float ret_lg2(int h) { return log2f(1.0f - exp2f(-5.0f - (float)h)); }
__device__ __forceinline__ void ret_sample_wave(Frame& F, int b, int h) {
    const int lane = F.lane; const bf16* prow = (const bf16*)(F.ws + WS_PROJ) + (size_t)(M + b) * PROJ_LD + h * HD + lane;
    const float qv = bf2f(prow[1536]), kv = bf2f(prow[2048]), vv = bf2f(prow[2560]), gv = bf2f(prow[3072]);
    const float* rot = (const float*)(F.ws + WS_ROT) + ((size_t)4096 * 32 + (lane & 31)) * 2; const float cs = rot[0], sn = rot[1];
    const float qo = __shfl_xor(qv, 32), ko = __shfl_xor(kv, 32);
    const float q = lane < 32 ? qv * cs - qo * sn : qo * sn + qv * cs;
    const float k = (lane < 32 ? kv * cs - ko * sn : ko * sn + kv * cs) * 0.125f;
    const float gam = exp2f(ret_lg2(h));
    const float qk = wave_sum(q * k);
    const float* S0 = F.in[IN_SRET] + ((size_t)(b * NH + h) * HD) * HD + lane; float* S1 = F.out + O_SRS + ((size_t)(b * NH + h) * HD) * HD + lane;
    float cross = 0.f;
#pragma unroll 8
    for (int d = 0; d < HD; ++d) { const float s0 = S0[(size_t)d * HD]; const float qd = __shfl(q, d), kd = __shfl(k, d); cross += qd * s0; S1[(size_t)d * HD] = gam * s0 + kd * vv; }
    const float o = qk * vv + gam * cross;
    const float mean = wave_sum(o) * (1.0f / HD); const float dv = o - mean; const float var = wave_sum(dv * dv) * (1.0f / HD);
    const float y = (gv / (1.0f + __expf(-gv))) * dv * (1.0f / sqrtf(var + GN_EPS));
    ((bf16*)(F.ws + WS_AO))[(size_t)(M + b) * D + FW + h * HD + lane] = (bf16)f2bf(y);
}

constexpr int RT_QI = 0, RT_KI = 18432, RT_KT = 34816, RT_VT = 51200, RT_SI = 67584, RT_OF = 76800, RT_UP = 109568, RT_END = 125952;
__device__ __forceinline__ void ret_unit(Frame& F, int b, int h, int g) {
    refresh(F);
    const int lane = F.lane, r32 = lane & 31, hi = lane >> 5, wid = F.wave, tid = F.tid;
    LAS unsigned char* lds = F.lds;
    const float lg2 = ret_lg2(h);
    const bf16* Pb = (const bf16*)(F.ws + WS_PROJ) + (size_t)b * T * PROJ_LD + h * HD;
    const float* rot = (const float*)(F.ws + WS_ROT);
    const int tok = tid >> 2, dc = tid & 3;
    const int qb = wid & 3, eh = wid >> 2;
    const int dh = wid & 1, eh2 = (wid >> 1) & 1, kh = wid >> 2;
    const int trl = ((lane >> 4) & 1) * 32 + (lane & 3) * 8 + (4 * hi + ((lane & 15) >> 2)) * 64;
    float fac[16];
#pragma unroll
    for (int i = 0; i < 16; ++i) fac[i] = exp2f((float)(32 * qb + crow(i, hi) + 1) * lg2);
    const float g128 = exp2f(128.0f * lg2);
    const float kdec = exp2f((float)(127 - tok) * lg2) * 0.125f;
    f32x16 S;
#pragma unroll
    for (int i = 0; i < 16; ++i) S[i] = 0.f;
    __syncthreads();
    for (int i = tid; i < 9216 / 4; i += NWAVES * 64) ((LAS unsigned*)(lds + RT_SI))[i] = 0u;
    const int c_end = 4 * g + 4;
    for (int c = 0; c < c_end; ++c) {
        const bool full = c >= 4 * g;
        { const int t = 128 * c + tok; const bf16* prow = Pb + (size_t)t * PROJ_LD;
          const float* rp = rot + ((size_t)t * 32 + 8 * dc) * 2;
          float cs[8], sn[8];
#pragma unroll
          for (int e = 0; e < 4; ++e) { const f32x4 r4 = *(const f32x4*)(rp + 4 * e); cs[2 * e] = r4.x; sn[2 * e] = r4.y; cs[2 * e + 1] = r4.z; sn[2 * e + 1] = r4.w; }
          { const v4u a = *(const GAS v4u*)(prow + 2048 + 8 * dc), bq = *(const GAS v4u*)(prow + 2048 + 32 + 8 * dc);
            v4u o1, o2, t1, t2;
#pragma unroll
            for (int e = 0; e < 4; ++e) { const float x1a = bflo(a[e]), x1b = bfhi(a[e]), x2a = bflo(bq[e]), x2b = bfhi(bq[e]);
                const float y1a = x1a * cs[2 * e] - x2a * sn[2 * e], y1b = x1b * cs[2 * e + 1] - x2b * sn[2 * e + 1];
                const float y2a = x1a * sn[2 * e] + x2a * cs[2 * e], y2b = x1b * sn[2 * e + 1] + x2b * cs[2 * e + 1];
                o1[e] = pk2(y1a * 0.125f, y1b * 0.125f); o2[e] = pk2(y2a * 0.125f, y2b * 0.125f); t1[e] = pk2(y1a * kdec, y1b * kdec); t2[e] = pk2(y2a * kdec, y2b * kdec); }
            if (full) { *(LAS v4u*)(lds + RT_KI + dc * 2048 + tok * 16) = o1; *(LAS v4u*)(lds + RT_KI + (dc + 4) * 2048 + tok * 16) = o2; }
            *(LAS v4u*)(lds + RT_KT + tok * 64 + 16 * dc) = t1; *(LAS v4u*)(lds + RT_KT + 8192 + tok * 64 + 16 * dc) = t2; }
          { const v4u a = *(const GAS v4u*)(prow + 2560 + 8 * dc), bq = *(const GAS v4u*)(prow + 2560 + 32 + 8 * dc);
            *(LAS v4u*)(lds + RT_VT + tok * 64 + 16 * dc) = a; *(LAS v4u*)(lds + RT_VT + 8192 + tok * 64 + 16 * dc) = bq; }
          if (full) { const v4u a = *(const GAS v4u*)(prow + 1536 + 8 * dc), bq = *(const GAS v4u*)(prow + 1536 + 32 + 8 * dc);
            v4u o1, o2;
#pragma unroll
            for (int e = 0; e < 4; ++e) { const float x1a = bflo(a[e]), x1b = bfhi(a[e]), x2a = bflo(bq[e]), x2b = bfhi(bq[e]);
                o1[e] = pk2(x1a * cs[2 * e] - x2a * sn[2 * e], x1b * cs[2 * e + 1] - x2b * sn[2 * e + 1]);
                o2[e] = pk2(x1a * sn[2 * e] + x2a * cs[2 * e], x1b * sn[2 * e + 1] + x2b * cs[2 * e + 1]); }
            *(LAS v4u*)(lds + RT_QI + tok * 144 + 16 * dc) = o1; *(LAS v4u*)(lds + RT_QI + tok * 144 + 64 + 16 * dc) = o2; }
        }
        __syncthreads();
        if (full) {
            f32x16 acc;
#pragma unroll
            for (int i = 0; i < 16; ++i) acc[i] = 0.f;
            const LAS unsigned char* qp = lds + RT_QI + (32 * qb + r32) * 144 + 16 * hi;
            bf16x8 qf[4];
#pragma unroll
            for (int s = 0; s < 4; ++s) qf[s] = *(const LAS bf16x8*)(qp + 32 * s);
            { const LAS unsigned char* sp = lds + RT_SI + (32 * eh + r32) * 144 + 16 * hi;
#pragma unroll
              for (int s = 0; s < 4; ++s) acc = MFMA32(qf[s], *(const LAS bf16x8*)(sp + 32 * s), acc); }
#pragma unroll
            for (int i = 0; i < 16; ++i) acc[i] *= fac[i];
            const int iq = 32 * qb + r32;
            for (int kt = 0; kt <= (qb >> 1); ++kt) {
                f32x16 p0, p1;
#pragma unroll
                for (int i = 0; i < 16; ++i) { p0[i] = 0.f; p1[i] = 0.f; }
                const LAS unsigned char* kp = lds + RT_KI + hi * 2048 + (64 * kt + r32) * 16;
#pragma unroll
                for (int d0 = 0; d0 < 4; ++d0) { p0 = MFMA32(*(const LAS bf16x8*)(kp + d0 * 4096), qf[d0], p0); p1 = MFMA32(*(const LAS bf16x8*)(kp + d0 * 4096 + 512), qf[d0], p1); }
#pragma unroll
                for (int i = 0; i < 16; ++i) { const int j = 64 * kt + crow(i, hi);
                    p0[i] = j <= iq ? p0[i] * exp2f((float)(iq - j) * lg2) : 0.f; p1[i] = j + 32 <= iq ? p1[i] * exp2f((float)(iq - j - 32) * lg2) : 0.f; }
                bf16x8 pa[4];
#pragma unroll
                for (int s = 0; s < 2; ++s) { v4u w0, w1;
#pragma unroll
                    for (int e = 0; e < 4; ++e) { w0[e] = pk2(p0[8 * s + 2 * e], p0[8 * s + 2 * e + 1]); w1[e] = pk2(p1[8 * s + 2 * e], p1[8 * s + 2 * e + 1]); }
                    pa[s] = __builtin_bit_cast(bf16x8, w0); pa[2 + s] = __builtin_bit_cast(bf16x8, w1); }
                const LAS unsigned char* vp = lds + RT_VT + eh * 8192 + (64 * kt) * 64 + trl;
#pragma unroll
                for (int ks = 0; ks < 4; ++ks) acc = MFMA32(pa[ks], cat8(vtr(vp + ks * 1024), vtr(vp + ks * 1024 + 512)), acc);
            }
            LAS float* of = (LAS float*)(lds + RT_OF);
#pragma unroll
            for (int i = 0; i < 16; ++i) of[(32 * qb + crow(i, hi)) * 64 + 32 * eh + r32] = acc[i];
        }
        f32x16 u;
#pragma unroll
        for (int i = 0; i < 16; ++i) u[i] = 0.f;
        { const LAS unsigned char* ap = lds + RT_KT + dh * 8192 + (64 * kh) * 64 + trl; const LAS unsigned char* bp = lds + RT_VT + eh2 * 8192 + (64 * kh) * 64 + trl;
#pragma unroll
          for (int ks = 0; ks < 4; ++ks) u = MFMA32(cat8(vtr(ap + ks * 1024), vtr(ap + ks * 1024 + 512)), cat8(vtr(bp + ks * 1024), vtr(bp + ks * 1024 + 512)), u); }
        if (wid >= 4) { LAS float* up = (LAS float*)(lds + RT_UP) + (wid - 4) * 1024;
#pragma unroll
            for (int i = 0; i < 16; ++i) up[i * 64 + lane] = u[i]; }
        __syncthreads();
        if (full) {
            const LAS float* of = (const LAS float*)(lds + RT_OF) + tok * 64 + 16 * dc; float v[16]; float s = 0.f;
#pragma unroll
            for (int e = 0; e < 4; ++e) { const f32x4 x = *(const LAS f32x4*)(of + 4 * e); v[4 * e] = x.x; v[4 * e + 1] = x.y; v[4 * e + 2] = x.z; v[4 * e + 3] = x.w; s += (x.x + x.y) + (x.z + x.w); }
            s += __shfl_xor(s, 1); s += __shfl_xor(s, 2); const float mean = s * (1.0f / HD); float q2 = 0.f;
#pragma unroll
            for (int e = 0; e < 16; ++e) { v[e] -= mean; q2 += v[e] * v[e]; }
            q2 += __shfl_xor(q2, 1); q2 += __shfl_xor(q2, 2); const float rstd = 1.0f / sqrtf(q2 * (1.0f / HD) + GN_EPS);
            const int t = 128 * c + tok; const bf16* gp = Pb + (size_t)t * PROJ_LD + 3072 + 16 * dc;
            const v4u g0 = *(const GAS v4u*)gp, g1 = *(const GAS v4u*)(gp + 8); v4u o0, o1;
#pragma unroll
            for (int e = 0; e < 4; ++e) { const float ga = bflo(g0[e]), gb = bfhi(g0[e]), gc = bflo(g1[e]), gd = bfhi(g1[e]);
                o0[e] = pk2(ga / (1.0f + __expf(-ga)) * v[2 * e] * rstd, gb / (1.0f + __expf(-gb)) * v[2 * e + 1] * rstd);
                o1[e] = pk2(gc / (1.0f + __expf(-gc)) * v[8 + 2 * e] * rstd, gd / (1.0f + __expf(-gd)) * v[8 + 2 * e + 1] * rstd); }
            bf16* ao = (bf16*)(F.ws + WS_AO) + (size_t)(b * T + t) * D + FW + h * HD + 16 * dc;
            *(GAS v4u*)ao = o0; *(GAS v4u*)(ao + 8) = o1;
        }
        if (wid < 4) { const LAS float* up = (const LAS float*)(lds + RT_UP) + wid * 1024;
#pragma unroll
            for (int i = 0; i < 16; ++i) S[i] = g128 * S[i] + (u[i] + up[i * 64 + lane]);
            LAS unsigned char* sp = lds + RT_SI + (32 * eh2 + r32) * 144 + (32 * dh + 4 * hi) * 2;
#pragma unroll
            for (int q = 0; q < 4; ++q) { v2u w; w.x = pk2(S[4 * q], S[4 * q + 1]); w.y = pk2(S[4 * q + 2], S[4 * q + 3]); *(LAS v2u*)(sp + 16 * q) = w; } }
        __syncthreads();
    }
    if (g == 7 && wid < 4) { float* so = F.out + O_SRP + ((size_t)(b * NH + h) * HD) * HD;
#pragma unroll
        for (int i = 0; i < 16; ++i) so[(size_t)(32 * dh + crow(i, hi)) * HD + 32 * eh2 + r32] = S[i]; }
}

__device__ __forceinline__ void mixer_phase(Frame& F) {
    const int v = F.vcu;
    { const int gw = F.vcu * NWAVES + F.wave; if (gw < DBATCH * NH) ret_sample_wave(F, gw >> 3, gw & 7); }
    for (int uu = v; uu < 256; uu += F.G) {
        const int bh = uu >> 3, s = uu & 7;
        decode_unit(F, uu >> 3, uu & 7);
        ret_unit(F, bh >> 3, bh & 7, s);
        fox_unit(F, bh >> 3, bh & 7, s);
        fox_unit(F, bh >> 3, bh & 7, 15 - s);
    }
}

#ifndef MK_PER_PHASE
#define MK_PER_PHASE 0
#endif
constexpr int N_PHASES = 22;
struct Args { const float* in[22]; float* out; unsigned char* ws; int ph_lo, ph_hi; };
__global__ void __launch_bounds__(NWAVES * 64, 2) mk_fwd(Args args) {
    extern __shared__ __attribute__((aligned(16))) unsigned char lds_raw[];
    Frame F;
    F.lds = (LAS unsigned char*)lds_raw;
    F.MISC = (volatile LAS unsigned*)(F.lds + MISC_OFF);
    F.tid = threadIdx.x; F.lane = F.tid & 63; F.wave = __builtin_amdgcn_readfirstlane(F.tid >> 6);
    F.G = gridDim.x; { const int bx = blockIdx.x; F.vcu = (F.G % 8 == 0) ? (bx % 8) * (F.G / 8) + bx / 8 : bx; }
#pragma unroll
    for (int i = 0; i < 22; ++i) F.in[i] = args.in[i];
    F.out = args.out; F.ws = args.ws; F.ctl = (gu32*)(args.ws + WS_CTL);
    for (int u = F.tid; u < (LDS_BYTES - LDSCTL_OFF) / 4; u += NWAVES * 64) ((LAS unsigned*)(F.lds + LDSCTL_OFF))[u] = 0u;
    __syncthreads();
    XcdBarrier bar; bar.bar = (unsigned*)(F.ctl + CW_BAR); bar.x = 0; bar.st = nullptr;
    if (!MK_PER_PHASE) bar = xcd_barrier_post((unsigned*)(F.ctl + CW_BAR), F.MISC + 8);
    const int lo = args.ph_lo, hi = args.ph_hi;
    int ph = 0;
#define IN(k) (lo <= (k) && (k) < hi)
#define SEAM() do { if (!MK_PER_PHASE && IN(ph) && IN(ph + 1)) xcd_barrier(bar); ++ph; } while (0)
#define REFRESH() do { int t_ = F.tid; asm volatile("" : "+v"(t_)); F.tid = t_; F.lane = t_ & 63; F.wave = __builtin_amdgcn_readfirstlane(t_ >> 6); int v_ = F.vcu; asm volatile("" : "+s"(v_)); F.vcu = v_; } while (0)

    bf16* const H = (bf16*)(F.ws + WS_H); bf16* const HID = (bf16*)(F.ws + WS_HID); bf16* const PROJ = (bf16*)(F.ws + WS_PROJ);
    bf16* const AO = (bf16*)(F.ws + WS_AO); bf16* const FB = (bf16*)(F.ws + WS_F);

    if (IN(ph)) { REFRESH(); p0_prologue(F); }
    SEAM();
    if (IN(ph)) { REFRESH(); modulate_phase(F); }
    SEAM();

    for (int sub = 0; sub < 4; ++sub) {
        const int l = sub >> 1, j = (sub & 1) * 2, wi = sub;
        if (IN(ph)) { REFRESH();
            pg8::Gemm g{H, (const bf16*)(F.ws + WS_WFI) + (size_t)wi * 2 * DFF * D, MP, 2 * DFF, D}; pg8::StaticOrder S; S.init(MP, 2 * DFF, F.G, (int)blockIdx.x);
            pg8::EpiSwiGLU E{HID, DFF};
            pg8::gemm_phase<pg8::EpiSwiGLU, pg8::StaticOrder, true, true>(F.lds + RING_OFF, g, S, E);
        }
        SEAM();
        if (IN(ph)) { REFRESH();
            const bf16* Wt = (const bf16*)(F.ws + WS_WFO) + (size_t)wi * D * DFF;
            pg8::Gemm g{HID, Wt, M, D, DFF}; pg8::StaticOrder S; S.init(M, D, F.G, (int)blockIdx.x);
            pg8::EpiPlain E{FB, D};
            pg8::gemm_phase<pg8::EpiPlain, pg8::StaticOrder, true, true>(F.lds + RING_OFF, g, S, E);
            __syncthreads();
            if (F.vcu >= F.G - 32) small_gemm32(F, HID + (size_t)M * DFF, Wt, DFF, F.vcu - (F.G - 32));
        }
        SEAM();
        if (IN(ph)) { REFRESH(); const bool last = (sub == 3); ln_phase(F, l, j, sub == 0, last, j == 0 ? l : l + 1, j == 0 ? 1 : 0); }
        SEAM();
        if (sub == 0) {
            if (IN(ph)) { REFRESH();
                pg8::Gemm g{H, (const bf16*)(F.ws + WS_WIE), MP, EVEN_PAD, D}; pg8::StaticOrder S; S.init(MP, EVEN_PAD, F.G, (int)blockIdx.x);
                pg8::EpiEvenProj E{PROJ, F.out + O_KP, F.out + O_VP, F.out + O_LFP, F.out + O_KS, F.out + O_VS, F.out + O_LFS, (float*)(F.ws + WS_LOGF), F.in[IN_BF], QSCALE};
                pg8::gemm_phase<pg8::EpiEvenProj, pg8::StaticOrder, true, true>(F.lds + RING_OFF, g, S, E);
            }
            SEAM();
            if (IN(ph)) { REFRESH(); mixer_phase(F); }
            SEAM();
        }
        if (sub == 2) {
            if (IN(ph)) { REFRESH();
                pg8::Gemm g{H, (const bf16*)(F.ws + WS_WIO), MP, 3 * D, D}; pg8::StaticOrder S; S.init(MP, 3 * D, F.G, (int)blockIdx.x);
                pg8::EpiOddProj E{PROJ, (bf16*)(F.ws + WS_PROJ + 64 * MiB), F.out + O_SCP, F.out + O_SCS};
                pg8::gemm_phase<pg8::EpiOddProj, pg8::StaticOrder, true, true>(F.lds + RING_OFF, g, S, E);
            }
            SEAM();
            if (IN(ph)) { REFRESH(); conv_phase(F); }
            SEAM();
        }
        if (sub == 0 || sub == 2) {
            if (IN(ph)) { REFRESH();
                const bf16* Wt = (const bf16*)(F.ws + (sub == 0 ? WS_WOE : WS_WOO));
                pg8::Gemm g{AO, Wt, M, D, D}; pg8::StaticOrder S; S.init(M, D, F.G, (int)blockIdx.x);
                pg8::EpiPlain E{FB, D};
                pg8::gemm_phase<pg8::EpiPlain, pg8::StaticOrder, true, true>(F.lds + RING_OFF, g, S, E);
                __syncthreads();
                if (F.vcu >= F.G - 32) small_gemm32(F, AO + (size_t)M * D, Wt, D, F.vcu - (F.G - 32));
            }
            SEAM();
            if (IN(ph)) { REFRESH(); ln_phase(F, l, 1, false, false, l, 2); }
            SEAM();
        }
    }
#undef IN
#undef SEAM
}

extern "C" void kernel_launch(void* const* d_in, const int* in_sizes, int n_in, void* d_out, int out_size, void* d_ws, size_t ws_size, hipStream_t stream) {
    static int grid = 0;
    if (grid == 0) {
        if (n_in != 22 || (size_t)out_size != O_END || ws_size < WS_END) { fprintf(stderr, "kernel_launch: unexpected shapes (n_in %d out %d ws %zu); nothing launched\n", n_in, out_size, ws_size); grid = -1; return; }
        int dev = 0, cus = 0, per_cu = 0;
        if (hipGetDevice(&dev) != hipSuccess || hipDeviceGetAttribute(&cus, hipDeviceAttributeMultiprocessorCount, dev) != hipSuccess) { grid = -1; return; }
        if (hipFuncSetAttribute((const void*)mk_fwd, hipFuncAttributeMaxDynamicSharedMemorySize, LDS_BYTES) != hipSuccess) { fprintf(stderr, "kernel_launch: hipFuncSetAttribute failed\n"); grid = -1; return; }
        if (hipOccupancyMaxActiveBlocksPerMultiprocessor(&per_cu, (const void*)mk_fwd, NWAVES * 64, LDS_BYTES) != hipSuccess || per_cu < 1) { fprintf(stderr, "kernel_launch: occupancy query reports %d\n", per_cu); }
        (void)hipGetLastError();
        grid = cus;
        if (grid != 256) fprintf(stderr, "kernel_launch: %d CUs (built for 256)\n", grid);
    }
    if (grid < 0) return;
    (void)in_sizes;
    if (hipMemsetAsync((char*)d_ws + WS_CTL, 0, CTL_ZERO_BYTES, stream) != hipSuccess) return;
    Args a{};
    for (int i = 0; i < 22; ++i) a.in[i] = (const float*)d_in[i];
    a.out = (float*)d_out; a.ws = (unsigned char*)d_ws;
#if MK_PER_PHASE
    for (int p = 0; p < N_PHASES; ++p) { a.ph_lo = p; a.ph_hi = p + 1; hipLaunchKernelGGL(mk_fwd, dim3(grid), dim3(NWAVES * 64), LDS_BYTES, stream, a); }
#else
    a.ph_lo = 0; a.ph_hi = N_PHASES;
    hipLaunchKernelGGL(mk_fwd, dim3(grid), dim3(NWAVES * 64), LDS_BYTES, stream, a);
#endif
    const hipError_t le = hipPeekAtLastError();
    if (le != hipSuccess) fprintf(stderr, "kernel_launch: launch failed: %s\n", hipGetErrorName(le));
}
```

```cpp
#include <hip/hip_runtime.h>
#include <cstdio>
#include <cstdint>
namespace pg8 {
#define PG8_LAS __attribute__((address_space(3)))
typedef unsigned short bf16_t;
typedef short bf16x8 __attribute__((ext_vector_type(8)));
typedef float f32x4 __attribute__((ext_vector_type(4)));
typedef unsigned u32x4 __attribute__((ext_vector_type(4)));
constexpr int BM = 256, BK = 64, HALF = 128, HTB = HALF * BK * 2  , STAGE_BYTES = 8 * HTB, NXCD = 8, WGM = 8;

__host__ __device__ __forceinline__ int lds_byte(int r, int c) { const int st = (r >> 4) * 2 + (c >> 5), rr = r & 15, cc = c & 31, ob = rr * 64 + cc * 2; return st * 1024 + (ob ^ (((ob >> 9) & 1) << 5)); }
__host__ __device__ __forceinline__ void stage_rc(int b, int& R, int& C) { const int st = b / 1024, sb = b % 1024, swz = sb ^ (((sb >> 9) & 1) << 5); R = (st >> 1) * 16 + swz / 64; C = (st & 1) * 32 + (swz % 64) / 2; }
__host__ __device__ __forceinline__ int perm32(int rho) { const int n = rho >> 4, i = rho & 15; return 8 * (i >> 2) + 4 * n + (i & 3); }

struct Unit { int pm, pn; };
struct Gemm { const bf16_t* A; const bf16_t* Bt; int M, N, K; };

struct StaticOrder {
    int nM, nN, nwg, G, c;
    __host__ __device__ void init(int M, int N, int G_, int c_) { nM = M / BM; nN = N / BM; nwg = nM * nN; G = G_; c = c_; }
    __host__ __device__ bool next(int i, Unit& u) const {
        const long L = (long)i * G + c; if (L >= nwg) return false;
        int wgid = (int)L; { const int q = nwg / NXCD, r = nwg % NXCD, xcd = wgid % NXCD, off = wgid / NXCD; wgid = (xcd < r ? xcd * (q + 1) : r * (q + 1) + (xcd - r) * q) + off; }
        const int nig = WGM * nN, gid = wgid / nig, fm = gid * WGM, gsz = (nM - fm) < WGM ? (nM - fm) : WGM;
        u.pm = fm + ((wgid % nig) % gsz); u.pn = (wgid % nig) / gsz; return true;
    }
    __device__ __forceinline__ void a_ready(const Unit&) const {}
    __device__ __forceinline__ void done(const Unit&) const {}
};

__device__ __forceinline__ unsigned cvt_pk_bf16(float lo, float hi) { unsigned r; asm volatile("v_cvt_pk_bf16_f32 %0, %1, %2" : "=v"(r) : "v"(lo), "v"(hi)); return r; }
typedef float f32x2 __attribute__((ext_vector_type(2)));

constexpr int EP_M = 16384;
constexpr int EP_MS = EP_M + 32;
__device__ __forceinline__ u32x4 pack8(const f32x4& v0, const f32x4& v1) { u32x4 w; w.x = cvt_pk_bf16(v0[0], v0[1]); w.y = cvt_pk_bf16(v0[2], v0[3]); w.z = cvt_pk_bf16(v1[0], v1[1]); w.w = cvt_pk_bf16(v1[2], v1[3]); return w; }
__device__ __forceinline__ float silu_f(float a) { return a * __builtin_amdgcn_rcpf(1.0f + __builtin_amdgcn_exp2f(-1.4426950408889634f * a)); }
__device__ __forceinline__ float log_sigmoid_f(float x) { return fminf(x, 0.f) - log1pf(__expf(-fabsf(x))); }

struct EpiPlain {
    static constexpr bool PERM = true, AFTER_DRAIN = false;
    bf16_t* O; int ldc;
    __device__ __forceinline__ void operator()(const f32x4 (&acc)[2][2][4][2], const Unit& u, int wr, int wc, int fr, int fq) const {
        const int row0 = u.pm * BM + wr * 64 + fr, col0 = u.pn * BM + wc * 32 + 8 * fq;
#pragma unroll
        for (int ai = 0; ai < 2; ++ai)
#pragma unroll
            for (int m = 0; m < 4; ++m) { bf16_t* rowp = O + (size_t)(row0 + ai * HALF + m * 16) * ldc + col0;
#pragma unroll
                for (int bj = 0; bj < 2; ++bj) *(u32x4*)(rowp + bj * HALF) = pack8(acc[ai][bj][m][0], acc[ai][bj][m][1]); }
    }
};
struct EpiSwiGLU {
    static constexpr bool PERM = true, AFTER_DRAIN = false;
    bf16_t* O; int ldc;
    __device__ __forceinline__ void operator()(const f32x4 (&acc)[2][2][4][2], const Unit& u, int wr, int wc, int fr, int fq) const {
        const int row0 = u.pm * BM + wr * 64 + fr, col0 = u.pn * HALF + wc * 32 + 8 * fq;
#pragma unroll
        for (int ai = 0; ai < 2; ++ai)
#pragma unroll
            for (int m = 0; m < 4; ++m) { bf16_t* rowp = O + (size_t)(row0 + ai * HALF + m * 16) * ldc + col0;
                f32x4 h0, h1;
#pragma unroll
                for (int e = 0; e < 4; ++e) { h0[e] = silu_f(acc[ai][0][m][0][e]) * acc[ai][1][m][0][e]; h1[e] = silu_f(acc[ai][0][m][1][e]) * acc[ai][1][m][1][e]; }
                *(u32x4*)rowp = pack8(h0, h1); }
    }
};
struct EpiEvenProj {
    static constexpr bool PERM = true, AFTER_DRAIN = false;
    bf16_t* P; float* outK; float* outV; float* outLf; float* outKs; float* outVs; float* outLfs; float* logf_ws; const float* bfor; float qscale;
    __device__ __forceinline__ void operator()(const f32x4 (&acc)[2][2][4][2], const Unit& u, int wr, int wc, int fr, int fq) const {
        const int row0 = u.pm * BM + wr * 64 + fr; const int pn = u.pn;
        if (pn < 14) {
            const float sc = pn < 2 ? qscale : 1.0f; const int col0 = pn * BM + wc * 32 + 8 * fq;
            const bool kv = (pn >= 2 && pn < 6);
#pragma unroll
            for (int ai = 0; ai < 2; ++ai)
#pragma unroll
                for (int m = 0; m < 4; ++m) { const int row = row0 + ai * HALF + m * 16; bf16_t* rowp = P + (size_t)row * 3584 + col0;
#pragma unroll
                    for (int bj = 0; bj < 2; ++bj) { const f32x4 v0 = acc[ai][bj][m][0] * sc, v1 = acc[ai][bj][m][1] * sc; *(u32x4*)(rowp + bj * HALF) = pack8(v0, v1);
                        if (kv && row < EP_MS) { const int c = col0 + bj * HALF - (pn < 4 ? 512 : 1024);
                            float* dst = row < EP_M ? ((pn < 4 ? outK : outV) + (size_t)row * 512 + c) : ((pn < 4 ? outKs : outVs) + (size_t)(row - EP_M) * 512 + c);
                            *(f32x4*)dst = v0; *(f32x4*)(dst + 4) = v1; } } }
        } else if (wc == 0 && fq == 0) {
            const f32x4 b0 = *(const f32x4*)bfor, b1 = *(const f32x4*)(bfor + 4);
#pragma unroll
            for (int ai = 0; ai < 2; ++ai)
#pragma unroll
                for (int m = 0; m < 4; ++m) { const int row = row0 + ai * HALF + m * 16; f32x4 l0, l1;
#pragma unroll
                    for (int e = 0; e < 4; ++e) { l0[e] = log_sigmoid_f(acc[ai][0][m][0][e] + b0[e]); l1[e] = log_sigmoid_f(acc[ai][0][m][1][e] + b1[e]); }
                    *(f32x4*)(logf_ws + (size_t)row * 8) = l0; *(f32x4*)(logf_ws + (size_t)row * 8 + 4) = l1;
                    if (row < EP_MS) { float* dst = row < EP_M ? outLf + (size_t)row * 8 : outLfs + (size_t)(row - EP_M) * 8; *(f32x4*)dst = l0; *(f32x4*)(dst + 4) = l1; } }
        }
    }
};
struct EpiOddProj {
    static constexpr bool PERM = true, AFTER_DRAIN = false;
    bf16_t* UP; bf16_t* BG; float* outConv; float* outConvS;
    __device__ __forceinline__ void operator()(const f32x4 (&acc)[2][2][4][2], const Unit& u, int wr, int wc, int fr, int fq) const {
        const int row0 = u.pm * BM + wr * 64 + fr; const int pn = u.pn;
        if (pn < 8) {
            const int col0 = pn * HALF + wc * 32 + 8 * fq;
#pragma unroll
            for (int ai = 0; ai < 2; ++ai)
#pragma unroll
                for (int m = 0; m < 4; ++m) { const int row = row0 + ai * HALF + m * 16;
                    const f32x4 h0 = acc[ai][0][m][0] * acc[ai][1][m][0], h1 = acc[ai][0][m][1] * acc[ai][1][m][1];
                    *(u32x4*)(UP + (size_t)row * 1024 + col0) = pack8(h0, h1);
                    if (row < EP_M) { const int t = row & 4095; if (t >= 4094) { float* dst = outConv + ((size_t)(row >> 12) * 2 + (t - 4094)) * 1024 + col0; *(f32x4*)dst = h0; *(f32x4*)(dst + 4) = h1; } }
                    else if (row < EP_MS) { float* dst = outConvS + ((size_t)(row - EP_M) * 2 + 1) * 1024 + col0; *(f32x4*)dst = h0; *(f32x4*)(dst + 4) = h1; } }
        } else {
            const int col0 = (pn - 8) * BM + wc * 32 + 8 * fq;
#pragma unroll
            for (int ai = 0; ai < 2; ++ai)
#pragma unroll
                for (int m = 0; m < 4; ++m) { bf16_t* rowp = BG + (size_t)(row0 + ai * HALF + m * 16) * 1024 + col0;
#pragma unroll
                    for (int bj = 0; bj < 2; ++bj) *(u32x4*)(rowp + bj * HALF) = pack8(acc[ai][bj][m][0], acc[ai][bj][m][1]); }
        }
    }
};
template <class Epi, class Sched, bool ALIGN_EPI = false, bool SP2 = false>
__device__ __forceinline__ void gemm_phase(PG8_LAS unsigned char* lds, const Gemm g, const Sched& S, const Epi& E) {
    int tid_l = threadIdx.x; asm volatile("" : "+v"(tid_l)); const int tid = tid_l, wid = __builtin_amdgcn_readfirstlane(tid >> 6), lane = tid & 63, wr = wid >> 2, wc = wid & 3, fr = lane & 15, fq = lane >> 4;
    const int K = g.K, nt = K / BK;
    unsigned voffA[2], voffB[2];
#pragma unroll
    for (int i = 0; i < 2; ++i) { int R, C; stage_rc(tid * 16 + i * 8192, R, C); const int Rb = Epi::PERM ? ((R & ~31) + perm32(R & 31)) : R;
        voffA[i] = (unsigned)(R * K + C) * 2u; voffB[i] = (unsigned)(Rb * K + C) * 2u; }
    const size_t kstep = (size_t)(BK * 2);
    const size_t hstep = (size_t)HALF * K * 2;
    const size_t tstep = 2 * hstep;
    const unsigned ldsw = (unsigned)wid * 1024u;
    const int aoff = lds_byte(wr * 64 + fr, fq * 8), boff = lds_byte(wc * 32 + fr, fq * 8);
#define PG8_SA(b, h) (((b) * 2 + (h)) * HTB)
#define PG8_SB(b, h) ((4 + (b) * 2 + (h)) * HTB)
#define PG8_STAGE(bufoff, gbase, voff) do { _Pragma("unroll") for (int _i = 0; _i < 2; ++_i) \
        __builtin_amdgcn_global_load_lds((const unsigned*)((const char*)(gbase) + (voff)[_i]), (PG8_LAS unsigned*)(lds + (bufoff) + ldsw + _i * 8192), 16, 0, 0); } while (0)
#define PG8_LDA(dst, b, h) do { _Pragma("unroll") for (int m = 0; m < 4; ++m) _Pragma("unroll") for (int k = 0; k < 2; ++k) dst[m][k] = *(const PG8_LAS bf16x8*)(lds + PG8_SA(b, h) + aoff + m * 2048 + k * 1024); } while (0)
#define PG8_LDB(dst, b, h) do { _Pragma("unroll") for (int n = 0; n < 2; ++n) _Pragma("unroll") for (int k = 0; k < 2; ++k) dst[n][k] = *(const PG8_LAS bf16x8*)(lds + PG8_SB(b, h) + boff + n * 2048 + k * 1024); } while (0)
#define PG8_MMA(ai, bj, At, Bt) do { __builtin_amdgcn_s_setprio(1); _Pragma("unroll") for (int m = 0; m < 4; ++m) _Pragma("unroll") for (int n = 0; n < 2; ++n) _Pragma("unroll") for (int k = 0; k < 2; ++k) \
        acc[ai][bj][m][n] = __builtin_amdgcn_mfma_f32_16x16x32_bf16(Bt[n][k], At[m][k], acc[ai][bj][m][n], 0, 0, 0); __builtin_amdgcn_s_setprio(0); } while (0)
#define PG8_WAIT_V(n) asm volatile("s_waitcnt vmcnt(" #n ")" ::: "memory")
#define PG8_WAIT_L(n) asm volatile("s_waitcnt lgkmcnt(" #n ")" ::: "memory")
#define PG8_BAR __builtin_amdgcn_s_barrier()
#define PG8_SCHED __builtin_amdgcn_sched_barrier(0)
    Unit cur, nxt; int ui = 0;
    if (!S.next(0, cur)) return;
    f32x4 acc[2][2][4][2];
#pragma unroll
    for (int a = 0; a < 2; ++a)
#pragma unroll
        for (int b = 0; b < 2; ++b)
#pragma unroll
            for (int m = 0; m < 4; ++m)
#pragma unroll
                for (int n = 0; n < 2; ++n) acc[a][b][m][n] = (f32x4){0.f, 0.f, 0.f, 0.f};
    bf16x8 At[4][2], B0[2][2], B1[2][2];
    const char* cA = (const char*)g.A + (size_t)cur.pm * tstep; const char* cB = (const char*)g.Bt + (size_t)cur.pn * tstep;
    S.a_ready(cur);
    if constexpr (SP2) {
        PG8_STAGE(PG8_SB(0, 0), cB, voffB); PG8_STAGE(PG8_SB(0, 1), cB + hstep, voffB); PG8_STAGE(PG8_SA(0, 0), cA, voffA); PG8_STAGE(PG8_SA(0, 1), cA + hstep, voffA);
        if (wr == 1) PG8_BAR;
        PG8_WAIT_V(2); PG8_BAR;
        PG8_STAGE(PG8_SB(1, 0), cB + kstep, voffB); PG8_STAGE(PG8_SA(1, 0), cA + kstep, voffA); PG8_STAGE(PG8_SB(1, 1), cB + hstep + kstep, voffB);
        PG8_WAIT_V(6); PG8_BAR;
    } else {
        PG8_STAGE(PG8_SB(0, 0), cB, voffB); PG8_STAGE(PG8_SA(0, 0), cA, voffA); PG8_STAGE(PG8_SB(0, 1), cB + hstep, voffB); PG8_STAGE(PG8_SA(0, 1), cA + hstep, voffA);
        if (wr == 1) PG8_BAR;
        PG8_WAIT_V(4); PG8_BAR;
        PG8_STAGE(PG8_SB(1, 0), cB + kstep, voffB); PG8_STAGE(PG8_SA(1, 0), cA + kstep, voffA); PG8_STAGE(PG8_SB(1, 1), cB + hstep + kstep, voffB);
        PG8_WAIT_V(6); PG8_BAR;
    }
    for (;;) {
        const bool has_next = S.next(ui + 1, nxt);
        const char* nA = has_next ? (const char*)g.A + (size_t)nxt.pm * tstep : cA; const char* nB = has_next ? (const char*)g.Bt + (size_t)nxt.pn * tstep : cB;
        for (int t = 0; t < nt; t += 2) {
            const bool last = (t == nt - 2);
            const char* a1 = cA + (size_t)(t + 1) * kstep;
            const char* a2 = last ? nA : cA + (size_t)(t + 2) * kstep; const char* b2 = last ? nB : cB + (size_t)(t + 2) * kstep;
            const char* a3 = a2 + kstep; const char* b3 = b2 + kstep;
            if (last && has_next) S.a_ready(nxt);
            if constexpr (SP2) {
            PG8_LDB(B0, 0, 0); PG8_LDB(B1, 0, 1); PG8_SCHED; PG8_LDA(At, 0, 0); PG8_STAGE(PG8_SA(1, 1), a1 + hstep, voffA);
            PG8_WAIT_V(8); PG8_WAIT_L(0); PG8_BAR; PG8_MMA(0, 0, At, B0); PG8_MMA(0, 1, At, B1); PG8_BAR; PG8_SCHED;
            PG8_LDA(At, 0, 1); PG8_STAGE(PG8_SB(0, 0), b2, voffB); PG8_STAGE(PG8_SB(0, 1), b2 + hstep, voffB); PG8_STAGE(PG8_SA(0, 0), a2, voffA);
            PG8_WAIT_V(8); PG8_WAIT_L(0); PG8_BAR; PG8_MMA(1, 0, At, B0); PG8_MMA(1, 1, At, B1); PG8_BAR; PG8_SCHED;
            PG8_LDB(B0, 1, 0); PG8_LDB(B1, 1, 1); PG8_SCHED; PG8_LDA(At, 1, 0); PG8_STAGE(PG8_SA(0, 1), a2 + hstep, voffA);
            PG8_WAIT_V(8); PG8_WAIT_L(0); PG8_BAR; PG8_MMA(0, 0, At, B0); PG8_MMA(0, 1, At, B1); PG8_BAR; PG8_SCHED;
            PG8_LDA(At, 1, 1); PG8_STAGE(PG8_SB(1, 0), b3, voffB); PG8_STAGE(PG8_SB(1, 1), b3 + hstep, voffB); PG8_STAGE(PG8_SA(1, 0), a3, voffA);
            PG8_WAIT_V(8); PG8_WAIT_L(0); PG8_BAR; PG8_MMA(1, 0, At, B0); PG8_MMA(1, 1, At, B1); PG8_BAR; PG8_SCHED;
            } else {
            PG8_LDB(B0, 0, 0); PG8_SCHED; PG8_LDA(At, 0, 0); PG8_STAGE(PG8_SA(1, 1), a1 + hstep, voffA);
            PG8_WAIT_L(8); PG8_BAR; PG8_WAIT_L(0); PG8_MMA(0, 0, At, B0); PG8_BAR; PG8_SCHED;
            PG8_LDB(B1, 0, 1); PG8_STAGE(PG8_SB(0, 0), b2, voffB);
            PG8_BAR; PG8_WAIT_L(0); PG8_MMA(0, 1, At, B1); PG8_BAR;
            PG8_LDA(At, 0, 1); PG8_STAGE(PG8_SA(0, 0), a2, voffA);
            PG8_BAR; PG8_WAIT_L(0); PG8_MMA(1, 0, At, B0); PG8_BAR; PG8_SCHED;
            PG8_STAGE(PG8_SB(0, 1), b2 + hstep, voffB);
            PG8_WAIT_V(6); PG8_BAR; PG8_MMA(1, 1, At, B1); PG8_BAR;
            PG8_LDB(B0, 1, 0); PG8_SCHED; PG8_LDA(At, 1, 0); PG8_STAGE(PG8_SA(0, 1), a2 + hstep, voffA);
            PG8_WAIT_L(8); PG8_BAR; PG8_WAIT_L(0); PG8_MMA(0, 0, At, B0); PG8_BAR; PG8_SCHED;
            PG8_LDB(B1, 1, 1); PG8_STAGE(PG8_SB(1, 0), b3, voffB);
            PG8_BAR; PG8_WAIT_L(0); PG8_MMA(0, 1, At, B1); PG8_BAR;
            PG8_LDA(At, 1, 1); PG8_STAGE(PG8_SA(1, 0), a3, voffA);
            PG8_BAR; PG8_WAIT_L(0); PG8_MMA(1, 0, At, B0); PG8_BAR; PG8_SCHED;
            PG8_STAGE(PG8_SB(1, 1), b3 + hstep, voffB);
            PG8_WAIT_V(6); PG8_BAR; PG8_MMA(1, 1, At, B1); PG8_BAR;
            }
        }
        if constexpr (ALIGN_EPI) { if (wr == 0) PG8_BAR; }
        if constexpr (!Epi::AFTER_DRAIN) { E(acc, cur, wr, wc, fr, fq); S.done(cur); }
        if (!has_next) break;
#pragma unroll
        for (int a = 0; a < 2; ++a)
#pragma unroll
            for (int b = 0; b < 2; ++b)
#pragma unroll
                for (int m = 0; m < 4; ++m)
#pragma unroll
                    for (int n = 0; n < 2; ++n) acc[a][b][m][n] = (f32x4){0.f, 0.f, 0.f, 0.f};
        cur = nxt; cA = nA; cB = nB; ++ui;
        if constexpr (ALIGN_EPI) { if (wr == 1) PG8_BAR; }
    }
    PG8_WAIT_V(0);
    if constexpr (!ALIGN_EPI) { if (wr == 0) PG8_BAR; }
    PG8_BAR;
    if constexpr (Epi::AFTER_DRAIN) { E.fused(acc, cur, wr, wc, fr, fq, lds, wid, lane); S.done(cur); }
#undef PG8_SA
#undef PG8_SB
#undef PG8_STAGE
#undef PG8_LDA
#undef PG8_LDB
#undef PG8_MMA
#undef PG8_WAIT_V
#undef PG8_WAIT_L
#undef PG8_BAR
#undef PG8_SCHED
}
}

constexpr int NWAVES = 8;
constexpr int D = 1024, BATCH = 4, T = 4096, DBATCH = 32, PAST = 8192, PAGE = 128, NPAGES = PAST / PAGE, NPHYS = 2560;
constexpr int HD = 64, NH = 8, FW = 512, DFF = 2816, NMOD = 9, NSEQ = BATCH + DBATCH;
constexpr int M = BATCH * T;
constexpr int MS = M + DBATCH;
constexpr int MP = M + 256;
constexpr int EVEN_IN = 3592, EVEN_PAD = 3840, PROJ_LD = 3584;
constexpr float LN_EPS = 1e-5f, GN_EPS = 1e-6f;
constexpr float ALPHA = 1.4142135623730951f;
constexpr float LOG2E = 1.4426950408889634f;
constexpr float QSCALE = 0.125f * LOG2E;

constexpr size_t O_Y = 0, O_YS = (size_t)M * D, O_KP = O_YS + (size_t)DBATCH * D, O_VP = O_KP + (size_t)M * FW, O_LFP = O_VP + (size_t)M * FW,
    O_SRP = O_LFP + (size_t)M * NH, O_SCP = O_SRP + (size_t)BATCH * NH * HD * HD, O_KS = O_SCP + (size_t)BATCH * 2 * D, O_VS = O_KS + (size_t)DBATCH * FW,
    O_LFS = O_VS + (size_t)DBATCH * FW, O_SRS = O_LFS + (size_t)DBATCH * NH, O_SCS = O_SRS + (size_t)DBATCH * NH * HD * HD, O_END = O_SCS + (size_t)DBATCH * 2 * D;
static_assert(O_END == 35004672, "output size");

constexpr size_t MiB = 1u << 20;
constexpr size_t WS_CTL = 0, CTL_ZERO_BYTES = 1 * MiB;
constexpr size_t WS_MODS = 2 * MiB;
constexpr size_t WS_ROT = 6 * MiB;
constexpr size_t WS_SF = 8 * MiB;
constexpr size_t WS_WFI = 16 * MiB;
constexpr size_t WS_WFO = 64 * MiB;
constexpr size_t WS_WIE = 88 * MiB;
constexpr size_t WS_WOE = 96 * MiB;
constexpr size_t WS_WIO = 98 * MiB;
constexpr size_t WS_WOO = 104 * MiB;
constexpr size_t WS_H = 112 * MiB;
constexpr size_t WS_HID = 148 * MiB;
constexpr size_t WS_PROJ = 240 * MiB;
constexpr size_t WS_AO = 356 * MiB;
constexpr size_t WS_F = 392 * MiB;
constexpr size_t WS_LOGF = 428 * MiB;
constexpr size_t WS_END = 432 * MiB;
static_assert(WS_WFI + 4ull * 5632 * 1024 * 2 <= WS_WFO && WS_WFO + 4ull * 1024 * 2816 * 2 <= WS_WIE && WS_WIE + 3840ull * 1024 * 2 <= WS_WOE && WS_WIO + 3072ull * 1024 * 2 <= WS_WOO, "ws map (weights)");
static_assert(WS_H + (size_t)MP * 1024 * 2 <= WS_HID && WS_HID + (size_t)MP * DFF * 2 <= WS_PROJ && WS_PROJ + (size_t)MP * PROJ_LD * 2 <= WS_AO && WS_AO + (size_t)MP * 1024 * 2 <= WS_F && WS_F + (size_t)M * 1024 * 2 <= WS_LOGF, "ws map");
constexpr int CW_TMO = 0, CW_CODE = 1, CW_BAR = 4096;

constexpr int RING_OFF = 0, RING_BYTES = 131072;
constexpr int LDSCTL_OFF = RING_BYTES, MISC_OFF = LDSCTL_OFF + 320;
constexpr int LDS_BYTES = 147456;

#define GAS __attribute__((address_space(1)))
#define LAS __attribute__((address_space(3)))
typedef unsigned short bf16;
typedef unsigned v4u __attribute__((ext_vector_type(4)));
typedef unsigned v2u __attribute__((ext_vector_type(2)));
typedef float f32x4 __attribute__((ext_vector_type(4)));
typedef float f32x16 __attribute__((ext_vector_type(16)));
typedef short bf16x8 __attribute__((ext_vector_type(8)));
typedef short s16x4 __attribute__((ext_vector_type(4)));
typedef GAS unsigned gu32;
#define RLX_AGENT __ATOMIC_RELAXED, __HIP_MEMORY_SCOPE_AGENT
#define LDS_WAIT() asm volatile("s_waitcnt lgkmcnt(0)" ::: "memory")
#define VM_WAIT() asm volatile("s_waitcnt vmcnt(0)" ::: "memory")
#define LBAR() asm volatile("s_waitcnt lgkmcnt(0)\n\ts_barrier" ::: "memory")
__device__ __forceinline__ unsigned f2bf(float f) { unsigned u = __builtin_bit_cast(unsigned, f); return (u + 0x7fffu + ((u >> 16) & 1u)) >> 16; }
__device__ __forceinline__ unsigned pk2(float lo, float hi) { return f2bf(lo) | (f2bf(hi) << 16); }
__device__ __forceinline__ float bf2f(unsigned short b) { return __builtin_bit_cast(float, (unsigned)b << 16); }
__device__ __forceinline__ float bflo(unsigned w) { return __builtin_bit_cast(float, w << 16); }
__device__ __forceinline__ float bfhi(unsigned w) { return __builtin_bit_cast(float, w & 0xffff0000u); }
__device__ __forceinline__ float wave_sum(float v) {
#pragma unroll
    for (int o = 1; o < 64; o <<= 1) v += __shfl_xor(v, o);
    return v;
}
__device__ __forceinline__ float ex2(float x) { return __builtin_amdgcn_exp2f(x); }
__device__ __forceinline__ int crow(int r, int hi) { return (r & 3) + 8 * (r >> 2) + 4 * hi; }
#define MFMA32(a, b, c) __builtin_amdgcn_mfma_f32_32x32x16_bf16((a), (b), (c), 0, 0, 0)
typedef short v4i16_t __attribute__((ext_vector_type(4)));
__device__ __forceinline__ s16x4 vtr(const LAS unsigned char* p) { return __builtin_bit_cast(s16x4, __builtin_amdgcn_ds_read_tr16_b64_v4i16((LAS v4i16_t*)p)); }
__device__ __forceinline__ bf16x8 cat8(s16x4 lo, s16x4 hi) { return (bf16x8){lo[0], lo[1], lo[2], lo[3], hi[0], hi[1], hi[2], hi[3]}; }
#define XB_TMO      128
#define XB_XCNT(j)  (256  + 64 * (j))
#define XB_XSUB(j)  (1280 + 64 * (j))
#define XB_XGEN(j)  (2304 + 64 * (j))
#define XB_TOP      3328
#define XB_TOPGEN   3392
#define XCD_BAR_WORDS 3456
#define XB_SPIN_CAP (1u << 18)

__device__ __forceinline__ unsigned xb_ld(unsigned* p)              { return __hip_atomic_load(p, __ATOMIC_RELAXED, __HIP_MEMORY_SCOPE_AGENT); }
__device__ __forceinline__ unsigned xb_add(unsigned* p, unsigned v) { return __hip_atomic_fetch_add(p, v, __ATOMIC_RELAXED, __HIP_MEMORY_SCOPE_AGENT); }
__device__ __forceinline__ unsigned xb_xcc_id() { return (unsigned)__builtin_amdgcn_s_getreg((3 << 11) | 20) & 0xFu; }
#define XB_SPIN(cond, bar) do { unsigned _sp = 0; while (cond) { __builtin_amdgcn_s_sleep(1); \
    if ((++_sp & 255u) == 0u) { if (xb_ld(&(bar)[XB_TMO])) break; if (_sp > XB_SPIN_CAP) { atomicAdd(&(bar)[XB_TMO], 1u); break; } } } } while (0)

struct XcdBarrier {
    unsigned* bar; unsigned x;
    volatile LAS unsigned* st;
};

__device__ __forceinline__ XcdBarrier xcd_barrier_post(unsigned* bar, volatile LAS unsigned* st) {
    XcdBarrier b; b.bar = bar; b.x = xb_xcc_id(); b.st = st;
    if (threadIdx.x == 0) (void)xb_add(&bar[XB_XCNT(b.x)], 1u);
    return b;
}
__device__ __forceinline__ void xcd_barrier_complete(unsigned* bar, unsigned x, unsigned& nloc, unsigned& nx) {
    const unsigned G = gridDim.x * gridDim.y * gridDim.z;
    unsigned sum, cnt, mine, sp = 0u;
    for (;;) {
        sum = 0u; cnt = 0u; mine = 0u;
#pragma unroll
        for (unsigned j = 0; j < 16; ++j) { const unsigned c = xb_ld(&bar[XB_XCNT(j)]); sum += c; cnt += (c > 0u) ? 1u : 0u; mine = (j == x) ? c : mine; }
        if (sum == G) break;
        __builtin_amdgcn_s_sleep(1);
        if ((++sp & 255u) == 0u) { if (xb_ld(&bar[XB_TMO])) break; if (sp > XB_SPIN_CAP) { atomicAdd(&bar[XB_TMO], 1u); break; } }
    }
    nloc = mine > 0u ? mine : 1u; nx = cnt > 0u ? cnt : 1u;
}

__device__ __forceinline__ void xcd_barrier(const XcdBarrier& b) {
    asm volatile("s_waitcnt vmcnt(0)" ::: "memory");
    __syncthreads();
    if (threadIdx.x == 0) {
        unsigned* bar = b.bar;
        __builtin_amdgcn_s_waitcnt(0);
        unsigned nloc = b.st[0], nx = b.st[1];
        if (nloc == 0u) { xcd_barrier_complete(bar, b.x, nloc, nx); b.st[0] = nloc; b.st[1] = nx; }
        const unsigned old = xb_add(&bar[XB_XSUB(b.x)], 1u);
        const unsigned gen = old / nloc;
        if (old + 1u == (gen + 1u) * nloc) {
            __builtin_amdgcn_fence(__ATOMIC_RELEASE, "agent");
            asm volatile("s_waitcnt vmcnt(0)" ::: "memory");
            const unsigned og = xb_add(&bar[XB_TOP], 1u);
            const unsigned tg = og / nx;
            if (og + 1u == (tg + 1u) * nx) xb_add(&bar[XB_TOPGEN], 1u);
            else XB_SPIN(xb_ld(&bar[XB_TOPGEN]) == tg, bar);
            __builtin_amdgcn_fence(__ATOMIC_ACQUIRE, "agent");
            xb_add(&bar[XB_XGEN(b.x)], 1u);
            asm volatile("s_waitcnt vmcnt(0)" ::: "memory");
        } else {
            XB_SPIN(xb_ld(&bar[XB_XGEN(b.x)]) == gen, bar);
            __builtin_amdgcn_fence(__ATOMIC_ACQUIRE, "agent");
            asm volatile("s_waitcnt vmcnt(0)" ::: "memory");
        }
    }
    __syncthreads();
}

struct Frame {
    LAS unsigned char* lds;
    volatile LAS unsigned* MISC;
    gu32* ctl;
    int tid, lane, wave, vcu, G;
    const float* in[22];
    float* out; unsigned char* ws;
};
#define IN_X 0
#define IN_XS 1
#define IN_CK 2
#define IN_CV 3
#define IN_CLF 4
#define IN_SRET 5
#define IN_SCONV 6
#define IN_PT 7
#define IN_CP 8
#define IN_CS 9
#define IN_WADA 10
#define IN_BADA 11
#define IN_WFI 12
#define IN_WFO 13
#define IN_LNG 14
#define IN_LNB 15
#define IN_WIE 16
#define IN_BF 17
#define IN_WOE 18
#define IN_WIO 19
#define IN_CW 20
#define IN_WOO 21

__device__ __forceinline__ void refresh(Frame& F) { int t = F.tid; asm volatile("" : "+v"(t)); F.tid = t; F.lane = t & 63; F.wave = __builtin_amdgcn_readfirstlane(t >> 6); }
__device__ __forceinline__ int seq_of(int r) { return r < M ? (r >> 12) : (BATCH + r - M); }
__device__ __forceinline__ const float* mods_ptr(const Frame& F, int l, int s, int chunk) { return (const float*)(F.ws + WS_MODS) + ((size_t)(l * NSEQ + s) * NMOD + chunk) * D; }

__device__ __forceinline__ void p0_block(const float* W, int K, int N, int k0, int n0, bf16* dst, LAS float* scr, int lane) {
#pragma unroll 8
    for (int i = 0; i < 32; ++i) { const int kk = 2 * i + (lane >> 5); scr[kk * 33 + (lane & 31)] = W[(size_t)(k0 + kk) * N + n0 + (lane & 31)]; }
    LDS_WAIT(); asm volatile("" ::: "memory");
    const int c = lane & 7;
#pragma unroll
    for (int j = 0; j < 4; ++j) { const int n = (lane >> 3) + 8 * j; const LAS float* s = scr + (8 * c) * 33 + n;
        v4u o; o.x = pk2(s[0 * 33], s[1 * 33]); o.y = pk2(s[2 * 33], s[3 * 33]); o.z = pk2(s[4 * 33], s[5 * 33]); o.w = pk2(s[6 * 33], s[7 * 33]);
        *(GAS v4u*)(dst + (size_t)n * K + k0 + 8 * c) = o; }
    LDS_WAIT(); asm volatile("" ::: "memory");
}
__device__ __forceinline__ int pair_row(int n0, int half_off) { return 256 * (n0 >> 7) + half_off + (n0 & 127); }

__device__ __forceinline__ void mods_unit(Frame& F, int u) {
    refresh(F);
    const int l = u / 144, c0 = 64 * (u % 144);
    const float* W = F.in[IN_WADA] + (size_t)l * D * (NMOD * D) + c0 + F.lane;
    const float* cp = F.in[IN_CP]; const float* cs = F.in[IN_CS];
    LAS float* tab = (LAS float*)F.lds;
    float acc[NSEQ];
#pragma unroll
    for (int s = 0; s < NSEQ; ++s) acc[s] = 0.f;
    for (int half = 0; half < 2; ++half) {
        __syncthreads();
        for (int s = 0; s < NSEQ; ++s) { const float cv = s < BATCH ? cp[s * D + 512 * half + F.tid] : cs[(s - BATCH) * D + 512 * half + F.tid]; tab[s * 512 + F.tid] = cv / (1.0f + __expf(-cv)); }
        __syncthreads();
        const int kb = 64 * F.wave;
#pragma unroll 2
        for (int k4 = 0; k4 < 16; ++k4) { const int kk = kb + 4 * k4; const float* wp = W + (size_t)(512 * half + kk) * (NMOD * D);
            const float w0 = wp[0], w1 = wp[NMOD * D], w2 = wp[2 * NMOD * D], w3 = wp[3 * NMOD * D];
#pragma unroll
            for (int s = 0; s < NSEQ; ++s) { const f32x4 c4 = *(const LAS f32x4*)(tab + s * 512 + kk); acc[s] += (w0 * c4.x + w1 * c4.y) + (w2 * c4.z + w3 * c4.w); } }
    }
    __syncthreads();
    LAS float* red = (LAS float*)F.lds;
#pragma unroll
    for (int s = 0; s < NSEQ; ++s) red[(F.wave * NSEQ + s) * 64 + F.lane] = acc[s];
    __syncthreads();
    float* mods = (float*)(F.ws + WS_MODS);
    for (int o = F.tid; o < NSEQ * 64; o += NWAVES * 64) { const int s = o >> 6, c = o & 63; float v = F.in[IN_BADA][l * NMOD * D + c0 + c];
#pragma unroll
        for (int w = 0; w < NWAVES; ++w) v += red[(w * NSEQ + s) * 64 + c];
        mods[(size_t)(l * NSEQ + s) * (NMOD * D) + c0 + c] = v; }
    __syncthreads();
}

__device__ __forceinline__ void p0_prologue(Frame& F) {
    for (int u = F.vcu; u < 288; u += F.G) mods_unit(F, u);
    LAS float* scr = (LAS float*)(F.lds + RING_OFF + F.wave * 16384);
    const int gw = F.vcu * NWAVES + F.wave, NGW = F.G * NWAVES;
    constexpr int I_FI = 16 * 176, I_FO = 44 * 32, I_IE = 16 * 112, I_SQ = 16 * 32, I_IO = 16 * 96;
    constexpr int NITEMS = 4 * I_FI + 4 * I_FO + I_IE + I_SQ + I_IO + I_SQ;
    for (int it = gw; it < NITEMS; it += NGW) {
        int r = it;
        if (r < 4 * I_FI) { const int mi = r / I_FI; r -= mi * I_FI; const int kb = r / 176, nb = r % 176, n0 = 32 * nb;
            const int drow = n0 < DFF ? pair_row(n0, 0) : pair_row(n0 - DFF, 128);
            p0_block(F.in[IN_WFI] + (size_t)mi * D * 2 * DFF, D, 2 * DFF, 64 * kb, n0, (bf16*)(F.ws + WS_WFI) + (size_t)mi * 2 * DFF * D + (size_t)drow * D, scr, F.lane); continue; }
        r -= 4 * I_FI;
        if (r < 4 * I_FO) { const int mi = r / I_FO; r -= mi * I_FO; const int kb = r / 32, nb = r % 32;
            p0_block(F.in[IN_WFO] + (size_t)mi * DFF * D, DFF, D, 64 * kb, 32 * nb, (bf16*)(F.ws + WS_WFO) + (size_t)mi * D * DFF + (size_t)(32 * nb) * DFF, scr, F.lane); continue; }
        r -= 4 * I_FO;
        if (r < I_IE) { const int kb = r / 112, nb = r % 112; const int n0 = nb < 48 ? 32 * nb : 1544 + 32 * (nb - 48), drow = nb < 48 ? 32 * nb : 1536 + 32 * (nb - 48);
            p0_block(F.in[IN_WIE], D, EVEN_IN, 64 * kb, n0, (bf16*)(F.ws + WS_WIE) + (size_t)drow * D, scr, F.lane); continue; }
        r -= I_IE;
        if (r < I_SQ) { const int kb = r / 32, nb = r % 32; p0_block(F.in[IN_WOE], D, D, 64 * kb, 32 * nb, (bf16*)(F.ws + WS_WOE) + (size_t)(32 * nb) * D, scr, F.lane); continue; }
        r -= I_SQ;
        if (r < I_IO) { const int kb = r / 96, nb = r % 96, n0 = 32 * nb;
            const int drow = n0 < 1024 ? 2048 + n0 : (n0 < 2048 ? pair_row(n0 - 1024, 0) : pair_row(n0 - 2048, 128));
            p0_block(F.in[IN_WIO], D, 3 * D, 64 * kb, n0, (bf16*)(F.ws + WS_WIO) + (size_t)drow * D, scr, F.lane); continue; }
        r -= I_IO;
        { const int kb = r / 32, nb = r % 32; p0_block(F.in[IN_WOO], D, D, 64 * kb, 32 * nb, (bf16*)(F.ws + WS_WOO) + (size_t)(32 * nb) * D, scr, F.lane); }
    }
    const int gt = F.vcu * (NWAVES * 64) + F.tid, NGT = F.G * NWAVES * 64;
    for (int i = gt; i < 256 * 128; i += NGT) { const int row = 3584 + (i >> 7), k8 = (i & 127) * 8; v4u o = {0u, 0u, 0u, 0u};
        if (row < 3592) { const float* w = F.in[IN_WIE] + (size_t)k8 * EVEN_IN + 1536 + (row - 3584);
            o.x = pk2(w[0], w[EVEN_IN]); o.y = pk2(w[2 * EVEN_IN], w[3 * EVEN_IN]); o.z = pk2(w[4 * EVEN_IN], w[5 * EVEN_IN]); o.w = pk2(w[6 * EVEN_IN], w[7 * EVEN_IN]); }
        *(GAS v4u*)((bf16*)(F.ws + WS_WIE) + (size_t)row * D + k8) = o; }
    for (int i = gt; i < (MP - MS) * 128; i += NGT) *(GAS v4u*)((bf16*)(F.ws + WS_H) + (size_t)MS * D + (size_t)i * 8) = (v4u){0u, 0u, 0u, 0u};
    for (int i = gt; i < 4097 * 32; i += NGT) { const int p = i >> 5, fi = i & 31; const float pos = p < 4096 ? (float)p : 8192.0f;
        const float inv = 1.0f / powf(10000.0f, (float)fi * (1.0f / 31.0f)); const float ang = pos * inv;
        double rev = (double)ang * 0.15915494309189535; rev -= floor(rev); const float rf = (float)rev;
        float* o = (float*)(F.ws + WS_ROT) + (size_t)i * 2; o[0] = __builtin_amdgcn_cosf(rf); o[1] = __builtin_amdgcn_sinf(rf); }
}

__device__ __forceinline__ void modulate_phase(Frame& F) {
    const int gw = F.vcu * NWAVES + F.wave, NGW = F.G * NWAVES;
    for (int r = gw; r < MS; r += NGW) {
        const float* x = r < M ? F.in[IN_X] + (size_t)r * D : F.in[IN_XS] + (size_t)(r - M) * D; const int s = seq_of(r);
        const float* sh = mods_ptr(F, 0, s, 0); const float* sc = mods_ptr(F, 0, s, 1);
        bf16* h = (bf16*)(F.ws + WS_H) + (size_t)r * D;
#pragma unroll
        for (int j = 0; j < 4; ++j) { const int c = 4 * F.lane + 256 * j; const f32x4 xv = *(const f32x4*)(x + c), a = *(const f32x4*)(sh + c), b = *(const f32x4*)(sc + c);
            const f32x4 y = xv * (b + 1.0f) + a; v2u o; o.x = pk2(y.x, y.y); o.y = pk2(y.z, y.w); *(GAS v2u*)(h + c) = o; }
    }
}
__device__ __forceinline__ void ln_phase(Frame& F, int l, int j, bool first, bool last, int nl, int nj) {
    const int gw = F.vcu * NWAVES + F.wave, NGW = F.G * NWAVES;
    const float gs = (j == 1) ? 1.0f : 0.5f;
    const float* lng = F.in[IN_LNG] + (size_t)(l * 3 + j) * D; const float* lnb = F.in[IN_LNB] + (size_t)(l * 3 + j) * D;
    for (int r = gw; r < MS; r += NGW) {
        const int s = seq_of(r);
        const float* x = first ? (r < M ? F.in[IN_X] + (size_t)r * D : F.in[IN_XS] + (size_t)(r - M) * D) : F.out + (size_t)r * D;
        const float* g = mods_ptr(F, l, s, 3 * j + 2);
        f32x4 v[4]; float sum = 0.f;
#pragma unroll
        for (int q = 0; q < 4; ++q) { const int c = 4 * F.lane + 256 * q; const f32x4 xv = *(const f32x4*)(x + c), gv = *(const f32x4*)(g + c); f32x4 fv;
            if (r < M) { const v2u fw = *(const GAS v2u*)((const bf16*)(F.ws + WS_F) + (size_t)r * D + c); fv = (f32x4){bflo(fw.x), bfhi(fw.x), bflo(fw.y), bfhi(fw.y)}; }
            else fv = *(const f32x4*)((const float*)(F.ws + WS_SF) + (size_t)(r - M) * D + c);
            v[q] = xv * ALPHA + gv * fv * gs; sum += (v[q].x + v[q].y) + (v[q].z + v[q].w); }
        const float mean = wave_sum(sum) * (1.0f / D); float s2 = 0.f;
#pragma unroll
        for (int q = 0; q < 4; ++q) { v[q] = v[q] - mean; s2 += (v[q].x * v[q].x + v[q].y * v[q].y) + (v[q].z * v[q].z + v[q].w * v[q].w); }
        const float rstd = 1.0f / sqrtf(wave_sum(s2) * (1.0f / D) + LN_EPS);
        float* xo = F.out + (size_t)r * D; bf16* h = (bf16*)(F.ws + WS_H) + (size_t)r * D;
        const float* sh = last ? lng : mods_ptr(F, nl, s, 3 * nj); const float* sc = last ? lng : mods_ptr(F, nl, s, 3 * nj + 1);
#pragma unroll
        for (int q = 0; q < 4; ++q) { const int c = 4 * F.lane + 256 * q; const f32x4 y = v[q] * rstd * *(const f32x4*)(lng + c) + *(const f32x4*)(lnb + c);
            *(f32x4*)(xo + c) = y;
            if (!last) { const f32x4 hv = y * (*(const f32x4*)(sc + c) + 1.0f) + *(const f32x4*)(sh + c); v2u o; o.x = pk2(hv.x, hv.y); o.y = pk2(hv.z, hv.w); *(GAS v2u*)(h + c) = o; } }
    }
}
__device__ __forceinline__ void conv_phase(Frame& F) {
    const int gw = F.vcu * NWAVES + F.wave, NGW = F.G * NWAVES;
    const bf16* UP = (const bf16*)(F.ws + WS_PROJ); const bf16* BG = (const bf16*)(F.ws + WS_PROJ + 64 * MiB); bf16* AO = (bf16*)(F.ws + WS_AO);
    const float* cw = F.in[IN_CW];
    for (int r = gw; r < MS; r += NGW) {
#pragma unroll
        for (int q = 0; q < 2; ++q) { const int c = 8 * F.lane + 512 * q;
            float w0[8], w1[8], w2[8], z[8];
#pragma unroll
            for (int e = 0; e < 8; ++e) { w0[e] = cw[c + e]; w1[e] = cw[D + c + e]; w2[e] = cw[2 * D + c + e]; }
            const v4u bg = *(const GAS v4u*)(BG + (size_t)r * D + c);
            if (r < M) { const int t = r & 4095; const v4u u0 = *(const GAS v4u*)(UP + (size_t)r * D + c);
                v4u u1 = {0u, 0u, 0u, 0u}, u2 = {0u, 0u, 0u, 0u};
                if (t >= 1) u1 = *(const GAS v4u*)(UP + (size_t)(r - 1) * D + c);
                if (t >= 2) u2 = *(const GAS v4u*)(UP + (size_t)(r - 2) * D + c);
#pragma unroll
                for (int e = 0; e < 4; ++e) { z[2 * e] = w2[2 * e] * bflo(u0[e]) + w1[2 * e] * bflo(u1[e]) + w0[2 * e] * bflo(u2[e]); z[2 * e + 1] = w2[2 * e + 1] * bfhi(u0[e]) + w1[2 * e + 1] * bfhi(u1[e]) + w0[2 * e + 1] * bfhi(u2[e]); }
            } else { const int b = r - M; const float* b0 = F.in[IN_SCONV] + (size_t)(b * 2) * D + c; const float* b1 = b0 + D; float* so = F.out + O_SCS + (size_t)(b * 2) * D + c;
#pragma unroll
                for (int e = 0; e < 8; ++e) { z[e] = w0[e] * b0[e] + w1[e] * b1[e] + w2[e] * so[D + e]; so[e] = b1[e]; } }
            v4u o;
#pragma unroll
            for (int e = 0; e < 4; ++e) o[e] = pk2(z[2 * e] * bflo(bg[e]), z[2 * e + 1] * bfhi(bg[e]));
            *(GAS v4u*)(AO + (size_t)r * D + c) = o; }
    }
}

__device__ __forceinline__ void small_gemm32(Frame& F, const bf16* As, const bf16* Bt, int K, int ct) {
    const int r32 = F.lane & 31, hi = F.lane >> 5; const int kper = K >> 3, steps = kper >> 4;
    const bf16* ap = As + (size_t)r32 * K + F.wave * kper + 8 * hi; const bf16* bp = Bt + (size_t)(32 * ct + r32) * K + F.wave * kper + 8 * hi;
    f32x16 acc;
#pragma unroll
    for (int i = 0; i < 16; ++i) acc[i] = 0.f;
#pragma unroll 2
    for (int s = 0; s < steps; ++s) { const bf16x8 a = *(const GAS bf16x8*)(ap + 16 * s), b = *(const GAS bf16x8*)(bp + 16 * s); acc = MFMA32(a, b, acc); }
    LAS float* red = (LAS float*)F.lds;
#pragma unroll
    for (int i = 0; i < 16; ++i) red[(F.wave * 16 + i) * 64 + F.lane] = acc[i];
    __syncthreads();
    float* SF = (float*)(F.ws + WS_SF);
    for (int o = F.tid; o < 1024; o += NWAVES * 64) { const int i = o >> 6, ln = o & 63; float v = 0.f;
#pragma unroll
        for (int w = 0; w < NWAVES; ++w) v += red[(w * 16 + i) * 64 + ln];
        SF[(size_t)crow(i, ln >> 5) * D + 32 * ct + (ln & 31)] = v; }
    __syncthreads();
}

__device__ __forceinline__ float block_incl_scan(Frame& F, float v, LAS float* scr) {
    float x = v;
#pragma unroll
    for (int o = 1; o < 64; o <<= 1) { const float y = __shfl_up(x, o); if (F.lane >= o) x += y; }
    if (F.lane == 63) scr[F.wave] = x;
    __syncthreads();
    float pre = 0.f;
#pragma unroll
    for (int w = 0; w < NWAVES; ++w) { const float t = scr[w]; if (w < F.wave) pre += t; }
    __syncthreads();
    return x + pre;
}

constexpr int AT_C2 = 0, AT_K = 16384, AT_V = 32768, AT_WSF = 49152, AT_OST = 51200, AT_SCAN = 83968;
__device__ __forceinline__ void fox_unit(Frame& F, int b, int h, int qb) {
    refresh(F);
    const int lane = F.lane, r32 = lane & 31, hi = lane >> 5, wid = F.wave, tid = F.tid;
    LAS unsigned char* lds = F.lds;
    LAS float* c2 = (LAS float*)(lds + AT_C2);
    const bf16* Pb = (const bf16*)(F.ws + WS_PROJ) + (size_t)b * T * PROJ_LD;
    const float* lf = (const float*)(F.ws + WS_LOGF) + (size_t)b * T * NH + h;
    const int nkeys = 256 * (qb + 1);
    __syncthreads();
    { float v[8]; float tot = 0.f;
#pragma unroll
      for (int e = 0; e < 8; ++e) { const int t = 8 * tid + e; v[e] = t < nkeys ? lf[(size_t)t * NH] * LOG2E : 0.f; tot += v[e]; }
      const float incl = block_incl_scan(F, tot, (LAS float*)(lds + AT_SCAN)); float run = incl - tot;
      if (8 * tid < nkeys) {
#pragma unroll
        for (int e = 0; e < 8; ++e) { run += v[e]; c2[8 * tid + e] = run; } }
    }
    const int q0w = 256 * qb + 32 * wid;
    const bf16* Qw = Pb + (size_t)(q0w + r32) * PROJ_LD + h * HD;
    bf16x8 qr[4];
#pragma unroll
    for (int d0 = 0; d0 < 4; ++d0) qr[d0] = *(const GAS bf16x8*)(Qw + d0 * 16 + hi * 8);
    const bf16* Kh = Pb + FW + h * HD; const bf16* Vh = Pb + 2 * FW + h * HD;
    const bf16* ksrc = Kh + (size_t)lane * PROJ_LD + wid * 8;
    const bf16* vsrc = Vh + (size_t)(16 * (wid & 3) + (lane >> 2)) * PROJ_LD + (wid >> 2) * 32 + (lane & 3) * 8;
    const int NT = 4 * qb + 4;
    v4u kreg = *(const GAS v4u*)ksrc, vreg = *(const GAS v4u*)vsrc;
    const int stoff = wid * 1024 + lane * 16;
    *(LAS v4u*)(lds + AT_K + stoff) = kreg; *(LAS v4u*)(lds + AT_V + stoff) = vreg;
    if (NT > 1) { kreg = *(const GAS v4u*)(ksrc + (size_t)64 * PROJ_LD); vreg = *(const GAS v4u*)(vsrc + (size_t)64 * PROJ_LD); }
    __syncthreads();
    const float cq2 = c2[q0w + r32];
    float m_run = -INFINITY, l_run = 0.f;
    f32x16 o0, o1;
#pragma unroll
    for (int i = 0; i < 16; ++i) { o0[i] = 0.f; o1[i] = 0.f; }
    LAS float* wsf = (LAS float*)(lds + AT_WSF) + wid * 64;
    const int kfo = hi * 1024 + r32 * 16;
    const int vfo = ((lane >> 4) & 1) * 32 + (lane & 3) * 8 + (4 * hi + ((lane & 15) >> 2)) * 64;
    for (int t = 0; t < NT; ++t) {
        const int cur = (t & 1) * 8192, nxt = 8192 - cur;
        if (t + 1 < NT) { *(LAS v4u*)(lds + AT_K + nxt + stoff) = kreg; *(LAS v4u*)(lds + AT_V + nxt + stoff) = vreg; }
        if (t + 2 < NT) { kreg = *(const GAS v4u*)(ksrc + (size_t)(t + 2) * 64 * PROJ_LD); vreg = *(const GAS v4u*)(vsrc + (size_t)(t + 2) * 64 * PROJ_LD); }
        if (64 * t <= q0w + 31) {
            f32x16 p0, p1;
#pragma unroll
            for (int g = 0; g < 4; ++g) { const f32x4 ca = *(const LAS f32x4*)(c2 + 64 * t + 8 * g + 4 * hi), cb = *(const LAS f32x4*)(c2 + 64 * t + 32 + 8 * g + 4 * hi);
#pragma unroll
                for (int e = 0; e < 4; ++e) { p0[4 * g + e] = cq2 - ca[e]; p1[4 * g + e] = cq2 - cb[e]; } }
            const LAS unsigned char* kp = lds + AT_K + cur + kfo;
#pragma unroll
            for (int d0 = 0; d0 < 4; ++d0) { const bf16x8 k0 = *(const LAS bf16x8*)(kp + d0 * 2048), k1 = *(const LAS bf16x8*)(kp + d0 * 2048 + 512);
                p0 = MFMA32(k0, qr[d0], p0); p1 = MFMA32(k1, qr[d0], p1); }
            if (64 * t + 63 > q0w) { const int q = q0w + r32;
#pragma unroll
                for (int i = 0; i < 16; ++i) { const int key = 64 * t + crow(i, hi); if (key > q) p0[i] = -INFINITY; if (key + 32 > q) p1[i] = -INFINITY; } }
            float mx = fmaxf(p0[0], p1[0]);
#pragma unroll
            for (int i = 1; i < 16; ++i) mx = fmaxf(mx, fmaxf(p0[i], p1[i]));
            mx = fmaxf(mx, __shfl_xor(mx, 32));
            const float m_new = fmaxf(m_run, mx); const float alpha = ex2(m_run - m_new); m_run = m_new;
            float ps = 0.f;
#pragma unroll
            for (int i = 0; i < 16; ++i) { p0[i] = ex2(p0[i] - m_new); p1[i] = ex2(p1[i] - m_new); ps += p0[i] + p1[i]; }
            l_run = l_run * alpha + ps;
            if (__any(alpha != 1.0f)) {
                if (hi == 0) wsf[r32] = alpha;
                LDS_WAIT();
#pragma unroll
                for (int i = 0; i < 16; ++i) { const float a = wsf[crow(i, hi)]; o0[i] *= a; o1[i] *= a; }
            }
            bf16x8 pa[4];
#pragma unroll
            for (int s = 0; s < 2; ++s) { v4u w0, w1;
#pragma unroll
                for (int e = 0; e < 4; ++e) { w0[e] = pk2(p0[8 * s + 2 * e], p0[8 * s + 2 * e + 1]); w1[e] = pk2(p1[8 * s + 2 * e], p1[8 * s + 2 * e + 1]); }
                pa[s] = __builtin_bit_cast(bf16x8, w0); pa[2 + s] = __builtin_bit_cast(bf16x8, w1); }
            const LAS unsigned char* vp = lds + AT_V + cur + vfo;
#pragma unroll
            for (int ks = 0; ks < 4; ++ks) {
                const bf16x8 va = cat8(vtr(vp + ks * 1024), vtr(vp + ks * 1024 + 512));
                const bf16x8 vb = cat8(vtr(vp + 4096 + ks * 1024), vtr(vp + 4096 + ks * 1024 + 512));
                o0 = MFMA32(pa[ks], va, o0); o1 = MFMA32(pa[ks], vb, o1); }
        }
        LBAR();
    }
    l_run += __shfl_xor(l_run, 32);
    if (hi == 0) wsf[32 + r32] = 1.0f / l_run;
    LDS_WAIT();
    bf16* Ow = (bf16*)(F.ws + WS_AO) + (size_t)(b * T + q0w) * D + h * HD;
    LAS bf16* stg = (LAS bf16*)(lds + AT_OST) + wid * 2048;
#pragma unroll
    for (int i = 0; i < 16; ++i) { const int orow = crow(i, hi); const float il = wsf[32 + orow];
        stg[orow * 64 + r32] = (bf16)f2bf(o0[i] * il); stg[orow * 64 + 32 + r32] = (bf16)f2bf(o1[i] * il); }
    LDS_WAIT();
#pragma unroll
    for (int i = 0; i < 4; ++i) { const int row = i * 8 + (lane >> 3), ch = lane & 7; const v4u v = *(const LAS v4u*)(stg + row * 64 + ch * 8); *(GAS v4u*)(Ow + (size_t)row * D + ch * 8) = v; }
}

constexpr int DC_D2 = 0, DC_MRG = 32768, DC_SCAN = 32768 + 33 * 68 * 4;
__device__ __forceinline__ void decode_unit(Frame& F, int b, int h) {
    refresh(F);
    const int lane = F.lane, wid = F.wave, tid = F.tid;
    LAS unsigned char* lds = F.lds;
    LAS float* d2 = (LAS float*)(lds + DC_D2);
    const int* pt = (const int*)F.in[IN_PT] + b * NPAGES;
    const float* clf = F.in[IN_CLF];
    const float lf_new = ((const float*)(F.ws + WS_LOGF))[(size_t)(M + b) * NH + h] * LOG2E;
    __syncthreads();
    { float v[16]; float tot = 0.f; const int j0 = 16 * tid; const int page = pt[j0 >> 7];
      const float* src = clf + ((size_t)page * PAGE + (j0 & 127)) * NH + h;
#pragma unroll
      for (int e = 0; e < 16; ++e) { v[e] = src[(size_t)e * NH] * LOG2E; tot += v[e]; }
      const float incl = block_incl_scan(F, tot, (LAS float*)(lds + DC_SCAN));
      LAS float* gt = (LAS float*)(lds + DC_SCAN) + 16;
      if (tid == NWAVES * 64 - 1) gt[0] = incl;
      __syncthreads();
      float run = (gt[0] - incl) + lf_new;
#pragma unroll
      for (int e = 15; e >= 0; --e) { d2[j0 + e] = run; run += v[e]; }
    }
    __syncthreads();
    const int sub = lane >> 4, c = lane & 15;
    const bf16* qrow = (const bf16*)(F.ws + WS_PROJ) + (size_t)(M + b) * PROJ_LD + h * HD + 4 * c;
    const v2u qw = *(const GAS v2u*)qrow;
    const float q0 = bflo(qw.x), q1 = bfhi(qw.x), q2 = bflo(qw.y), q3 = bfhi(qw.y);
    const float* ck = F.in[IN_CK]; const float* cv = F.in[IN_CV];
    float m_run = -INFINITY, l_run = 0.f; f32x4 acc = {0.f, 0.f, 0.f, 0.f};
    for (int pg = 0; pg < 8; ++pg) {
        const int page = pt[8 * wid + pg];
        const size_t pbase = ((size_t)page * PAGE * NH + h) * HD + 4 * c;
        const int jb = 1024 * wid + 128 * pg;
#pragma unroll 2
        for (int it = 0; it < 8; ++it) {
            f32x4 kv[4], vv[4];
#pragma unroll
            for (int u = 0; u < 4; ++u) { const size_t off = pbase + (size_t)(16 * it + 4 * u + sub) * (NH * HD);
                kv[u] = __builtin_nontemporal_load((const f32x4*)(ck + off)); vv[u] = __builtin_nontemporal_load((const f32x4*)(cv + off)); }
#pragma unroll
            for (int u = 0; u < 4; ++u) {
                float s = (kv[u].x * q0 + kv[u].y * q1) + (kv[u].z * q2 + kv[u].w * q3);
                s += __shfl_xor(s, 1); s += __shfl_xor(s, 2); s += __shfl_xor(s, 4); s += __shfl_xor(s, 8);
                s += d2[jb + 16 * it + 4 * u + sub];
                const float m_new = fmaxf(m_run, s); const float alpha = ex2(m_run - m_new), p = ex2(s - m_new); m_run = m_new;
                l_run = l_run * alpha + p; acc = acc * alpha + vv[u] * p;
            }
        }
    }
    LAS float* mrg = (LAS float*)(lds + DC_MRG);
    { LAS float* rec = mrg + (wid * 4 + sub) * 68; if (c == 0) { rec[0] = m_run; rec[1] = l_run; } *(LAS f32x4*)(rec + 4 + 4 * c) = acc; }
    if (wid == 0 && sub == 0) {
        const bf16* krow = (const bf16*)(F.ws + WS_PROJ) + (size_t)(M + b) * PROJ_LD + FW + h * HD + 4 * c; const bf16* vrow = krow + FW;
        const v2u kw = *(const GAS v2u*)krow, vw = *(const GAS v2u*)vrow;
        float s = (bflo(kw.x) * q0 + bfhi(kw.x) * q1) + (bflo(kw.y) * q2 + bfhi(kw.y) * q3);
        s += __shfl_xor(s, 1); s += __shfl_xor(s, 2); s += __shfl_xor(s, 4); s += __shfl_xor(s, 8);
        LAS float* rec = mrg + 32 * 68; if (c == 0) { rec[0] = s; rec[1] = 1.0f; } *(LAS f32x4*)(rec + 4 + 4 * c) = (f32x4){bflo(vw.x), bfhi(vw.x), bflo(vw.y), bfhi(vw.y)};
    }
    __syncthreads();
    if (tid < 64) { float mm = -INFINITY;
        for (int p = 0; p < 33; ++p) mm = fmaxf(mm, mrg[p * 68]);
        float L = 0.f, o = 0.f;
        for (int p = 0; p < 33; ++p) { const float w = ex2(mrg[p * 68] - mm); L += mrg[p * 68 + 1] * w; o += mrg[p * 68 + 4 + tid] * w; }
        ((bf16*)(F.ws + WS_AO))[(size_t)(M + b) * D + h * HD + tid] = (bf16)f2bf(o / L); }
}

__device__ __forceinline__ float ret_lg2(int h) { return log2f(1.0f - exp2f(-5.0f - (float)h)); }
__device__ __forceinline__ void ret_sample_wave(Frame& F, int b, int h) {
    const int lane = F.lane; const bf16* prow = (const bf16*)(F.ws + WS_PROJ) + (size_t)(M + b) * PROJ_LD + h * HD + lane;
    const float qv = bf2f(prow[1536]), kv = bf2f(prow[2048]), vv = bf2f(prow[2560]), gv = bf2f(prow[3072]);
    const float* rot = (const float*)(F.ws + WS_ROT) + ((size_t)4096 * 32 + (lane & 31)) * 2; const float cs = rot[0], sn = rot[1];
    const float qo = __shfl_xor(qv, 32), ko = __shfl_xor(kv, 32);
    const float q = lane < 32 ? qv * cs - qo * sn : qo * sn + qv * cs;
    const float k = (lane < 32 ? kv * cs - ko * sn : ko * sn + kv * cs) * 0.125f;
    const float gam = exp2f(ret_lg2(h));
    const float qk = wave_sum(q * k);
    const float* S0 = F.in[IN_SRET] + ((size_t)(b * NH + h) * HD) * HD + lane; float* S1 = F.out + O_SRS + ((size_t)(b * NH + h) * HD) * HD + lane;
    float cross = 0.f;
#pragma unroll 8
    for (int d = 0; d < HD; ++d) { const float s0 = S0[(size_t)d * HD]; const float qd = __shfl(q, d), kd = __shfl(k, d); cross += qd * s0; S1[(size_t)d * HD] = gam * s0 + kd * vv; }
    const float o = qk * vv + gam * cross;
    const float mean = wave_sum(o) * (1.0f / HD); const float dv = o - mean; const float var = wave_sum(dv * dv) * (1.0f / HD);
    const float y = (gv / (1.0f + __expf(-gv))) * dv * (1.0f / sqrtf(var + GN_EPS));
    ((bf16*)(F.ws + WS_AO))[(size_t)(M + b) * D + FW + h * HD + lane] = (bf16)f2bf(y);
}

constexpr int RT_QI = 0, RT_KI = 18432, RT_KT = 34816, RT_VT = 51200, RT_SI = 67584, RT_OF = 76800, RT_UP = 109568, RT_END = 125952;
__device__ __forceinline__ void ret_unit(Frame& F, int b, int h, int g) {
    refresh(F);
    const int lane = F.lane, r32 = lane & 31, hi = lane >> 5, wid = F.wave, tid = F.tid;
    LAS unsigned char* lds = F.lds;
    const float lg2 = ret_lg2(h);
    const bf16* Pb = (const bf16*)(F.ws + WS_PROJ) + (size_t)b * T * PROJ_LD + h * HD;
    const float* rot = (const float*)(F.ws + WS_ROT);
    const int tok = tid >> 2, dc = tid & 3;
    const int qb = wid & 3, eh = wid >> 2;
    const int dh = wid & 1, eh2 = (wid >> 1) & 1, kh = wid >> 2;
    const int trl = ((lane >> 4) & 1) * 32 + (lane & 3) * 8 + (4 * hi + ((lane & 15) >> 2)) * 64;
    float fac[16];
#pragma unroll
    for (int i = 0; i < 16; ++i) fac[i] = exp2f((float)(32 * qb + crow(i, hi) + 1) * lg2);
    const float g128 = exp2f(128.0f * lg2);
    const float kdec = exp2f((float)(127 - tok) * lg2) * 0.125f;
    f32x16 S;
#pragma unroll
    for (int i = 0; i < 16; ++i) S[i] = 0.f;
    __syncthreads();
    for (int i = tid; i < 9216 / 4; i += NWAVES * 64) ((LAS unsigned*)(lds + RT_SI))[i] = 0u;
    const int c_end = 4 * g + 4;
    for (int c = 0; c < c_end; ++c) {
        const bool full = c >= 4 * g;
        { const int t = 128 * c + tok; const bf16* prow = Pb + (size_t)t * PROJ_LD;
          const float* rp = rot + ((size_t)t * 32 + 8 * dc) * 2;
          float cs[8], sn[8];
#pragma unroll
          for (int e = 0; e < 4; ++e) { const f32x4 r4 = *(const f32x4*)(rp + 4 * e); cs[2 * e] = r4.x; sn[2 * e] = r4.y; cs[2 * e + 1] = r4.z; sn[2 * e + 1] = r4.w; }
          { const v4u a = *(const GAS v4u*)(prow + 2048 + 8 * dc), bq = *(const GAS v4u*)(prow + 2048 + 32 + 8 * dc);
            v4u o1, o2, t1, t2;
#pragma unroll
            for (int e = 0; e < 4; ++e) { const float x1a = bflo(a[e]), x1b = bfhi(a[e]), x2a = bflo(bq[e]), x2b = bfhi(bq[e]);
                const float y1a = x1a * cs[2 * e] - x2a * sn[2 * e], y1b = x1b * cs[2 * e + 1] - x2b * sn[2 * e + 1];
                const float y2a = x1a * sn[2 * e] + x2a * cs[2 * e], y2b = x1b * sn[2 * e + 1] + x2b * cs[2 * e + 1];
                o1[e] = pk2(y1a * 0.125f, y1b * 0.125f); o2[e] = pk2(y2a * 0.125f, y2b * 0.125f); t1[e] = pk2(y1a * kdec, y1b * kdec); t2[e] = pk2(y2a * kdec, y2b * kdec); }
            if (full) { *(LAS v4u*)(lds + RT_KI + dc * 2048 + tok * 16) = o1; *(LAS v4u*)(lds + RT_KI + (dc + 4) * 2048 + tok * 16) = o2; }
            *(LAS v4u*)(lds + RT_KT + tok * 64 + 16 * dc) = t1; *(LAS v4u*)(lds + RT_KT + 8192 + tok * 64 + 16 * dc) = t2; }
          { const v4u a = *(const GAS v4u*)(prow + 2560 + 8 * dc), bq = *(const GAS v4u*)(prow + 2560 + 32 + 8 * dc);
            *(LAS v4u*)(lds + RT_VT + tok * 64 + 16 * dc) = a; *(LAS v4u*)(lds + RT_VT + 8192 + tok * 64 + 16 * dc) = bq; }
          if (full) { const v4u a = *(const GAS v4u*)(prow + 1536 + 8 * dc), bq = *(const GAS v4u*)(prow + 1536 + 32 + 8 * dc);
            v4u o1, o2;
#pragma unroll
            for (int e = 0; e < 4; ++e) { const float x1a = bflo(a[e]), x1b = bfhi(a[e]), x2a = bflo(bq[e]), x2b = bfhi(bq[e]);
                o1[e] = pk2(x1a * cs[2 * e] - x2a * sn[2 * e], x1b * cs[2 * e + 1] - x2b * sn[2 * e + 1]);
                o2[e] = pk2(x1a * sn[2 * e] + x2a * cs[2 * e], x1b * sn[2 * e + 1] + x2b * cs[2 * e + 1]); }
            *(LAS v4u*)(lds + RT_QI + tok * 144 + 16 * dc) = o1; *(LAS v4u*)(lds + RT_QI + tok * 144 + 64 + 16 * dc) = o2; }
        }
        __syncthreads();
        if (full) {
            f32x16 acc;
#pragma unroll
            for (int i = 0; i < 16; ++i) acc[i] = 0.f;
            const LAS unsigned char* qp = lds + RT_QI + (32 * qb + r32) * 144 + 16 * hi;
            bf16x8 qf[4];
#pragma unroll
            for (int s = 0; s < 4; ++s) qf[s] = *(const LAS bf16x8*)(qp + 32 * s);
            { const LAS unsigned char* sp = lds + RT_SI + (32 * eh + r32) * 144 + 16 * hi;
#pragma unroll
              for (int s = 0; s < 4; ++s) acc = MFMA32(qf[s], *(const LAS bf16x8*)(sp + 32 * s), acc); }
#pragma unroll
            for (int i = 0; i < 16; ++i) acc[i] *= fac[i];
            const int iq = 32 * qb + r32;
            for (int kt = 0; kt <= (qb >> 1); ++kt) {
                f32x16 p0, p1;
#pragma unroll
                for (int i = 0; i < 16; ++i) { p0[i] = 0.f; p1[i] = 0.f; }
                const LAS unsigned char* kp = lds + RT_KI + hi * 2048 + (64 * kt + r32) * 16;
#pragma unroll
                for (int d0 = 0; d0 < 4; ++d0) { p0 = MFMA32(*(const LAS bf16x8*)(kp + d0 * 4096), qf[d0], p0); p1 = MFMA32(*(const LAS bf16x8*)(kp + d0 * 4096 + 512), qf[d0], p1); }
#pragma unroll
                for (int i = 0; i < 16; ++i) { const int j = 64 * kt + crow(i, hi);
                    p0[i] = j <= iq ? p0[i] * exp2f((float)(iq - j) * lg2) : 0.f; p1[i] = j + 32 <= iq ? p1[i] * exp2f((float)(iq - j - 32) * lg2) : 0.f; }
                bf16x8 pa[4];
#pragma unroll
                for (int s = 0; s < 2; ++s) { v4u w0, w1;
#pragma unroll
                    for (int e = 0; e < 4; ++e) { w0[e] = pk2(p0[8 * s + 2 * e], p0[8 * s + 2 * e + 1]); w1[e] = pk2(p1[8 * s + 2 * e], p1[8 * s + 2 * e + 1]); }
                    pa[s] = __builtin_bit_cast(bf16x8, w0); pa[2 + s] = __builtin_bit_cast(bf16x8, w1); }
                const LAS unsigned char* vp = lds + RT_VT + eh * 8192 + (64 * kt) * 64 + trl;
#pragma unroll
                for (int ks = 0; ks < 4; ++ks) acc = MFMA32(pa[ks], cat8(vtr(vp + ks * 1024), vtr(vp + ks * 1024 + 512)), acc);
            }
            LAS float* of = (LAS float*)(lds + RT_OF);
#pragma unroll
            for (int i = 0; i < 16; ++i) of[(32 * qb + crow(i, hi)) * 64 + 32 * eh + r32] = acc[i];
        }
        f32x16 u;
#pragma unroll
        for (int i = 0; i < 16; ++i) u[i] = 0.f;
        { const LAS unsigned char* ap = lds + RT_KT + dh * 8192 + (64 * kh) * 64 + trl; const LAS unsigned char* bp = lds + RT_VT + eh2 * 8192 + (64 * kh) * 64 + trl;
#pragma unroll
          for (int ks = 0; ks < 4; ++ks) u = MFMA32(cat8(vtr(ap + ks * 1024), vtr(ap + ks * 1024 + 512)), cat8(vtr(bp + ks * 1024), vtr(bp + ks * 1024 + 512)), u); }
        if (wid >= 4) { LAS float* up = (LAS float*)(lds + RT_UP) + (wid - 4) * 1024;
#pragma unroll
            for (int i = 0; i < 16; ++i) up[i * 64 + lane] = u[i]; }
        __syncthreads();
        if (full) {
            const LAS float* of = (const LAS float*)(lds + RT_OF) + tok * 64 + 16 * dc; float v[16]; float s = 0.f;
#pragma unroll
            for (int e = 0; e < 4; ++e) { const f32x4 x = *(const LAS f32x4*)(of + 4 * e); v[4 * e] = x.x; v[4 * e + 1] = x.y; v[4 * e + 2] = x.z; v[4 * e + 3] = x.w; s += (x.x + x.y) + (x.z + x.w); }
            s += __shfl_xor(s, 1); s += __shfl_xor(s, 2); const float mean = s * (1.0f / HD); float q2 = 0.f;
#pragma unroll
            for (int e = 0; e < 16; ++e) { v[e] -= mean; q2 += v[e] * v[e]; }
            q2 += __shfl_xor(q2, 1); q2 += __shfl_xor(q2, 2); const float rstd = 1.0f / sqrtf(q2 * (1.0f / HD) + GN_EPS);
            const int t = 128 * c + tok; const bf16* gp = Pb + (size_t)t * PROJ_LD + 3072 + 16 * dc;
            const v4u g0 = *(const GAS v4u*)gp, g1 = *(const GAS v4u*)(gp + 8); v4u o0, o1;
#pragma unroll
            for (int e = 0; e < 4; ++e) { const float ga = bflo(g0[e]), gb = bfhi(g0[e]), gc = bflo(g1[e]), gd = bfhi(g1[e]);
                o0[e] = pk2(ga / (1.0f + __expf(-ga)) * v[2 * e] * rstd, gb / (1.0f + __expf(-gb)) * v[2 * e + 1] * rstd);
                o1[e] = pk2(gc / (1.0f + __expf(-gc)) * v[8 + 2 * e] * rstd, gd / (1.0f + __expf(-gd)) * v[8 + 2 * e + 1] * rstd); }
            bf16* ao = (bf16*)(F.ws + WS_AO) + (size_t)(b * T + t) * D + FW + h * HD + 16 * dc;
            *(GAS v4u*)ao = o0; *(GAS v4u*)(ao + 8) = o1;
        }
        if (wid < 4) { const LAS float* up = (const LAS float*)(lds + RT_UP) + wid * 1024;
#pragma unroll
            for (int i = 0; i < 16; ++i) S[i] = g128 * S[i] + (u[i] + up[i * 64 + lane]);
            LAS unsigned char* sp = lds + RT_SI + (32 * eh2 + r32) * 144 + (32 * dh + 4 * hi) * 2;
#pragma unroll
            for (int q = 0; q < 4; ++q) { v2u w; w.x = pk2(S[4 * q], S[4 * q + 1]); w.y = pk2(S[4 * q + 2], S[4 * q + 3]); *(LAS v2u*)(sp + 16 * q) = w; } }
        __syncthreads();
    }
    if (g == 7 && wid < 4) { float* so = F.out + O_SRP + ((size_t)(b * NH + h) * HD) * HD;
#pragma unroll
        for (int i = 0; i < 16; ++i) so[(size_t)(32 * dh + crow(i, hi)) * HD + 32 * eh2 + r32] = S[i]; }
}

__device__ __forceinline__ void mixer_phase(Frame& F) {
    const int v = F.vcu;
    { const int gw = F.vcu * NWAVES + F.wave; if (gw < DBATCH * NH) ret_sample_wave(F, gw >> 3, gw & 7); }
    for (int uu = v; uu < 256; uu += F.G) {
        const int bh = uu >> 3, s = uu & 7;
        decode_unit(F, uu >> 3, uu & 7);
        ret_unit(F, bh >> 3, bh & 7, s);
        fox_unit(F, bh >> 3, bh & 7, s);
        fox_unit(F, bh >> 3, bh & 7, 15 - s);
    }
}

#ifndef MK_PER_PHASE
#define MK_PER_PHASE 0
#endif
constexpr int N_PHASES = 22;
struct Args { const float* in[22]; float* out; unsigned char* ws; int ph_lo, ph_hi; };
__global__ void __launch_bounds__(NWAVES * 64, 2) mk_fwd(Args args) {
    extern __shared__ __attribute__((aligned(16))) unsigned char lds_raw[];
    Frame F;
    F.lds = (LAS unsigned char*)lds_raw;
    F.MISC = (volatile LAS unsigned*)(F.lds + MISC_OFF);
    F.tid = threadIdx.x; F.lane = F.tid & 63; F.wave = __builtin_amdgcn_readfirstlane(F.tid >> 6);
    F.G = gridDim.x; { const int bx = blockIdx.x; F.vcu = (F.G % 8 == 0) ? (bx % 8) * (F.G / 8) + bx / 8 : bx; }
#pragma unroll
    for (int i = 0; i < 22; ++i) F.in[i] = args.in[i];
    F.out = args.out; F.ws = args.ws; F.ctl = (gu32*)(args.ws + WS_CTL);
    for (int u = F.tid; u < (LDS_BYTES - LDSCTL_OFF) / 4; u += NWAVES * 64) ((LAS unsigned*)(F.lds + LDSCTL_OFF))[u] = 0u;
    __syncthreads();
    XcdBarrier bar; bar.bar = (unsigned*)(F.ctl + CW_BAR); bar.x = 0; bar.st = nullptr;
    if (!MK_PER_PHASE) bar = xcd_barrier_post((unsigned*)(F.ctl + CW_BAR), F.MISC + 8);
    const int lo = args.ph_lo, hi = args.ph_hi;
    int ph = 0;
#define IN(k) (lo <= (k) && (k) < hi)
#define SEAM() do { if (!MK_PER_PHASE && IN(ph) && IN(ph + 1)) xcd_barrier(bar); ++ph; } while (0)
#define REFRESH() do { int t_ = F.tid; asm volatile("" : "+v"(t_)); F.tid = t_; F.lane = t_ & 63; F.wave = __builtin_amdgcn_readfirstlane(t_ >> 6); int v_ = F.vcu; asm volatile("" : "+s"(v_)); F.vcu = v_; } while (0)

    bf16* const H = (bf16*)(F.ws + WS_H); bf16* const HID = (bf16*)(F.ws + WS_HID); bf16* const PROJ = (bf16*)(F.ws + WS_PROJ);
    bf16* const AO = (bf16*)(F.ws + WS_AO); bf16* const FB = (bf16*)(F.ws + WS_F);

    if (IN(ph)) { REFRESH(); p0_prologue(F); }
    SEAM();
    if (IN(ph)) { REFRESH(); modulate_phase(F); }
    SEAM();

    for (int sub = 0; sub < 4; ++sub) {
        const int l = sub >> 1, j = (sub & 1) * 2, wi = sub;
        if (IN(ph)) { REFRESH();
            pg8::Gemm g{H, (const bf16*)(F.ws + WS_WFI) + (size_t)wi * 2 * DFF * D, MP, 2 * DFF, D}; pg8::StaticOrder S; S.init(MP, 2 * DFF, F.G, (int)blockIdx.x);
            pg8::EpiSwiGLU E{HID, DFF};
            pg8::gemm_phase<pg8::EpiSwiGLU, pg8::StaticOrder, true, true>(F.lds + RING_OFF, g, S, E);
        }
        SEAM();
        if (IN(ph)) { REFRESH();
            const bf16* Wt = (const bf16*)(F.ws + WS_WFO) + (size_t)wi * D * DFF;
            pg8::Gemm g{HID, Wt, M, D, DFF}; pg8::StaticOrder S; S.init(M, D, F.G, (int)blockIdx.x);
            pg8::EpiPlain E{FB, D};
            pg8::gemm_phase<pg8::EpiPlain, pg8::StaticOrder, true, true>(F.lds + RING_OFF, g, S, E);
            __syncthreads();
            if (F.vcu >= F.G - 32) small_gemm32(F, HID + (size_t)M * DFF, Wt, DFF, F.vcu - (F.G - 32));
        }
        SEAM();
        if (IN(ph)) { REFRESH(); const bool last = (sub == 3); ln_phase(F, l, j, sub == 0, last, j == 0 ? l : l + 1, j == 0 ? 1 : 0); }
        SEAM();
        if (sub == 0) {
            if (IN(ph)) { REFRESH();
                pg8::Gemm g{H, (const bf16*)(F.ws + WS_WIE), MP, EVEN_PAD, D}; pg8::StaticOrder S; S.init(MP, EVEN_PAD, F.G, (int)blockIdx.x);
                pg8::EpiEvenProj E{PROJ, F.out + O_KP, F.out + O_VP, F.out + O_LFP, F.out + O_KS, F.out + O_VS, F.out + O_LFS, (float*)(F.ws + WS_LOGF), F.in[IN_BF], QSCALE};
                pg8::gemm_phase<pg8::EpiEvenProj, pg8::StaticOrder, true, true>(F.lds + RING_OFF, g, S, E);
            }
            SEAM();
            if (IN(ph)) { REFRESH(); mixer_phase(F); }
            SEAM();
        }
        if (sub == 2) {
            if (IN(ph)) { REFRESH();
                pg8::Gemm g{H, (const bf16*)(F.ws + WS_WIO), MP, 3 * D, D}; pg8::StaticOrder S; S.init(MP, 3 * D, F.G, (int)blockIdx.x);
                pg8::EpiOddProj E{PROJ, (bf16*)(F.ws + WS_PROJ + 64 * MiB), F.out + O_SCP, F.out + O_SCS};
                pg8::gemm_phase<pg8::EpiOddProj, pg8::StaticOrder, true, true>(F.lds + RING_OFF, g, S, E);
            }
            SEAM();
            if (IN(ph)) { REFRESH(); conv_phase(F); }
            SEAM();
        }
        if (sub == 0 || sub == 2) {
            if (IN(ph)) { REFRESH();
                const bf16* Wt = (const bf16*)(F.ws + (sub == 0 ? WS_WOE : WS_WOO));
                pg8::Gemm g{AO, Wt, M, D, D}; pg8::StaticOrder S; S.init(M, D, F.G, (int)blockIdx.x);
                pg8::EpiPlain E{FB, D};
                pg8::gemm_phase<pg8::EpiPlain, pg8::StaticOrder, true, true>(F.lds + RING_OFF, g, S, E);
                __syncthreads();
                if (F.vcu >= F.G - 32) small_gemm32(F, AO + (size_t)M * D, Wt, D, F.vcu - (F.G - 32));
            }
            SEAM();
            if (IN(ph)) { REFRESH(); ln_phase(F, l, 1, false, false, l, 2); }
            SEAM();
        }
    }
#undef IN
#undef SEAM
}

extern "C" void kernel_launch(void* const* d_in, const int* in_sizes, int n_in, void* d_out, int out_size, void* d_ws, size_t ws_size, hipStream_t stream) {
    static int grid = 0;
    if (grid == 0) {
        if (n_in != 22 || (size_t)out_size != O_END || ws_size < WS_END) { fprintf(stderr, "kernel_launch: unexpected shapes (n_in %d out %d ws %zu); nothing launched\n", n_in, out_size, ws_size); grid = -1; return; }
        int dev = 0, cus = 0, per_cu = 0;
        if (hipGetDevice(&dev) != hipSuccess || hipDeviceGetAttribute(&cus, hipDeviceAttributeMultiprocessorCount, dev) != hipSuccess) { grid = -1; return; }
        if (hipFuncSetAttribute((const void*)mk_fwd, hipFuncAttributeMaxDynamicSharedMemorySize, LDS_BYTES) != hipSuccess) { fprintf(stderr, "kernel_launch: hipFuncSetAttribute failed\n"); grid = -1; return; }
        if (hipOccupancyMaxActiveBlocksPerMultiprocessor(&per_cu, (const void*)mk_fwd, NWAVES * 64, LDS_BYTES) != hipSuccess || per_cu < 1) { fprintf(stderr, "kernel_launch: occupancy query reports %d\n", per_cu); }
        (void)hipGetLastError();
        grid = cus;
        if (grid != 256) fprintf(stderr, "kernel_launch: %d CUs (built for 256)\n", grid);
    }
    if (grid < 0) return;
    (void)in_sizes;
    if (hipMemsetAsync((char*)d_ws + WS_CTL, 0, CTL_ZERO_BYTES, stream) != hipSuccess) return;
    Args a{};
    for (int i = 0; i < 22; ++i) a.in[i] = (const float*)d_in[i];
    a.out = (float*)d_out; a.ws = (unsigned char*)d_ws;
#if MK_PER_PHASE
    for (int p = 0; p < N_PHASES; ++p) { a.ph_lo = p; a.ph_hi = p + 1; hipLaunchKernelGGL(mk_fwd, dim3(grid), dim3(NWAVES * 64), LDS_BYTES, stream, a); }
#else
    a.ph_lo = 0; a.ph_hi = N_PHASES;
    hipLaunchKernelGGL(mk_fwd, dim3(grid), dim3(NWAVES * 64), LDS_BYTES, stream, a);
#endif
    const hipError_t le = hipPeekAtLastError();
    if (le != hipSuccess) fprintf(stderr, "kernel_launch: launch failed: %s\n", hipGetErrorName(le));
}
```
